# Optimizing an MI355X kernel written in HIP

```python
import jax, jax.numpy as jnp
from jax import lax
import numpy as np

D_MODEL = 1024
BATCH = 2
SEQ = 8192
DEPTH = 4

N_MIXERS = 3
N_LAYERS_A = len(range(0, DEPTH, N_MIXERS))
N_LAYERS_B = len(range(1, DEPTH, N_MIXERS))
N_LAYERS_C = len(range(2, DEPTH, N_MIXERS))
RMS_EPS = 1e-6
N_MOD = 6
FFN_HIDDEN = -(-8 * D_MODEL // (3 * 256)) * 256

NSA_HEAD_DIM = 64
NSA_HEADS = D_MODEL // NSA_HEAD_DIM
NSA_KV_GROUPS = 4
NSA_HEADS_PER_GROUP = NSA_HEADS // NSA_KV_GROUPS
CMP_LEN = 32
CMP_STRIDE = 16
CMP_HIDDEN = 2 * NSA_HEAD_DIM
SEL_LEN = 64
SEL_TOPK = 16
WINDOW = 512
NSA_Q_BLOCK = SEL_LEN
NSA_SCALE = NSA_HEAD_DIM ** -0.5
SEL_BIG = 1e9
NSA_IN = NSA_HEADS * NSA_HEAD_DIM + 6 * NSA_KV_GROUPS * NSA_HEAD_DIM + 3 * NSA_HEADS

RWKV_HEAD_DIM = 64
RWKV_HEADS = D_MODEL // RWKV_HEAD_DIM
DECAY_LORA = 64
AAA_LORA = 64
GATE_LORA = 128
RWKV_GN_EPS = 64e-5

POOL_WINDOWS = (2, 4, 8, 16)
POOL_GROUPS = len(POOL_WINDOWS)
POOL_GROUP_DIM = D_MODEL // POOL_GROUPS

kernel_name = "hybrid_nsa_rwkv7_pool_adaln_trunk"


def rms_norm(x, w):
    xf = x.astype(jnp.float32)
    y = xf * lax.rsqrt(jnp.mean(xf * xf, axis=-1, keepdims=True) + RMS_EPS)
    return y.astype(x.dtype) * w


def modulate(h, shift, scale):
    return h * (1 + scale[:, None, :]) + shift[:, None, :]


def masked_softmax(s, mask):
    s = jnp.where(mask, s.astype(jnp.float32), -jnp.inf)
    m = jnp.max(s, axis=-1, keepdims=True)
    m = jnp.where(jnp.isfinite(m), m, 0.0)
    e = jnp.where(mask, jnp.exp(s - m), 0.0)
    return e / jnp.maximum(jnp.sum(e, axis=-1, keepdims=True), 1e-30)


def swiglu(h, w_gate, w_up, w_down):
    return (jax.nn.silu(h @ w_gate) * (h @ w_up)) @ w_down


def nsa_mixer(h, w_in, cmp_pos, cmp_w1, cmp_w2, qk_norm, w_out):
    B, S, _ = h.shape
    H, G, HG, DK = NSA_HEADS, NSA_KV_GROUPS, NSA_HEADS_PER_GROUP, NSA_HEAD_DIM
    n_cmp = (S - CMP_LEN) // CMP_STRIDE + 1
    n_sel = S // SEL_LEN
    topk = min(SEL_TOPK, n_sel)
    qd, kd = H * DK, G * DK
    proj = h @ w_in
    q, k_c, v_c, k_s, v_s, k_w, v_w, gates = jnp.split(proj, [qd + i * kd for i in range(7)], axis=-1)

    def head_rms(z, w):
        zf = z.astype(jnp.float32)
        return (zf * lax.rsqrt(jnp.mean(zf * zf, axis=-1, keepdims=True) + RMS_EPS)).astype(z.dtype) * w

    q = head_rms(q.reshape(B, S, H, DK), qk_norm[0]).reshape(B, S, G, HG, DK).transpose(0, 2, 3, 1, 4)

    blk_idx = jnp.arange(n_cmp)[:, None] * CMP_STRIDE + jnp.arange(CMP_LEN)[None, :]

    def compress(kv, pos, w1, w2):
        blocks = kv.reshape(B, S, G, DK)[:, blk_idx] + pos[:, None, :]
        blocks = blocks.transpose(0, 3, 1, 2, 4).reshape(B, G, n_cmp, CMP_LEN * DK)
        return jax.nn.gelu(blocks @ w1) @ w2

    kc = head_rms(compress(k_c, cmp_pos[0], cmp_w1[0], cmp_w2[0]), qk_norm[1])
    vc = compress(v_c, cmp_pos[1], cmp_w1[1], cmp_w2[1])
    cmp_end = jnp.arange(n_cmp) * CMP_STRIDE + CMP_LEN - 1

    ks = head_rms(k_s.reshape(B, S, G, DK), qk_norm[2]).transpose(0, 2, 1, 3).reshape(B, G, n_sel, SEL_LEN, DK)
    vs = v_s.reshape(B, S, G, DK).transpose(0, 2, 1, 3).reshape(B, G, n_sel, SEL_LEN, DK)
    cmp_start = jnp.arange(n_cmp)[:, None] * CMP_STRIDE
    sel_start = jnp.arange(n_sel) * SEL_LEN
    overlap = ((cmp_start < sel_start[None, :] + SEL_LEN) & (cmp_start + CMP_LEN > sel_start[None, :])).astype(jnp.float32)

    pad = ((0, 0), (0, 0), (WINDOW, 0), (0, 0))
    kw = jnp.pad(head_rms(k_w.reshape(B, S, G, DK), qk_norm[3]).transpose(0, 2, 1, 3), pad)
    vw = jnp.pad(v_w.reshape(B, S, G, DK).transpose(0, 2, 1, 3), pad)

    gates = jax.nn.sigmoid(gates.astype(jnp.float32)).reshape(B, S, 3, G, HG).transpose(2, 0, 3, 4, 1)
    slopes = jnp.exp2(-8.0 * (jnp.arange(H, dtype=jnp.float32) + 1) / H).reshape(G, HG)
    b_ix = jnp.arange(B)[:, None, None, None]
    g_ix = jnp.arange(G)[None, :, None, None]
    j_sel = jnp.arange(n_sel)

    def block(qb):
        q0 = qb * NSA_Q_BLOCK
        t = q0 + jnp.arange(NSA_Q_BLOCK)
        qq = lax.dynamic_slice_in_dim(q, q0, NSA_Q_BLOCK, axis=3)
        dist_c = t[:, None] - cmp_end[None, :]
        s_c = jnp.einsum('bghqd,bgnd->bghqn', qq, kc) * NSA_SCALE - slopes[:, :, None, None] * dist_c
        p_c = masked_softmax(s_c, dist_c >= 0)
        o_c = jnp.einsum('bghqn,bgnd->bghqd', p_c, vc)
        imp = jnp.einsum('bghqn,nj->bgqj', p_c, overlap)
        valid = sel_start[None, :] <= t[:, None]
        forced = (j_sel == 0) | (j_sel == qb) | (j_sel == qb - 1)
        score = jnp.where(valid, jnp.where(forced, SEL_BIG, imp), -SEL_BIG)
        vals, idx = lax.top_k(score, topk)
        sel_ok = vals > -SEL_BIG / 2
        kg = ks[b_ix, g_ix, idx]
        vg = vs[b_ix, g_ix, idx]
        pos = idx[..., None] * SEL_LEN + jnp.arange(SEL_LEN)
        dist_s = t[None, None, :, None, None] - pos
        mask_s = sel_ok[..., None] & (dist_s >= 0)
        s_s = jnp.einsum('bghqd,bgqnld->bghqnl', qq, kg) * NSA_SCALE - slopes[None, :, :, None, None, None] * dist_s[:, :, None]
        p_s = masked_softmax(s_s.reshape(B, G, HG, NSA_Q_BLOCK, topk * SEL_LEN),
                             mask_s[:, :, None].reshape(B, G, 1, NSA_Q_BLOCK, topk * SEL_LEN))
        o_s = jnp.einsum('bghqnl,bgqnld->bghqd', p_s.reshape(B, G, HG, NSA_Q_BLOCK, topk, SEL_LEN), vg)
        kwin = lax.dynamic_slice_in_dim(kw, q0, WINDOW + NSA_Q_BLOCK, axis=2)
        vwin = lax.dynamic_slice_in_dim(vw, q0, WINDOW + NSA_Q_BLOCK, axis=2)
        p_k = q0 - WINDOW + jnp.arange(WINDOW + NSA_Q_BLOCK)
        dist_w = t[:, None] - p_k[None, :]
        mask_w = (dist_w >= 0) & (dist_w < WINDOW) & (p_k >= 0)[None, :]
        s_w = jnp.einsum('bghqd,bgkd->bghqk', qq, kwin) * NSA_SCALE - slopes[:, :, None, None] * dist_w
        o_w = jnp.einsum('bghqk,bgkd->bghqd', masked_softmax(s_w, mask_w), vwin)
        gb = lax.dynamic_slice_in_dim(gates, q0, NSA_Q_BLOCK, axis=4)[..., None]
        o = gb[0] * o_c + gb[1] * o_s + gb[2] * o_w
        return o.transpose(0, 3, 1, 2, 4).reshape(B, NSA_Q_BLOCK, H * DK)

    o = lax.map(block, jnp.arange(S // NSA_Q_BLOCK))
    o = o.transpose(1, 0, 2, 3).reshape(B, S, H * DK)
    return o @ w_out


def rwkv7_mixer(h, mu, w_rkv, w0, wd_a, wd_b, a0, wa_a, wa_b, wg_a, wg_b, k_k, k_a, r_k, ln_w, ln_b, w_out):
    B, S, D = h.shape
    H, N = RWKV_HEADS, RWKV_HEAD_DIM
    f32 = jnp.float32
    xx = jnp.pad(h, ((0, 0), (1, 0), (0, 0)))[:, :-1] - h
    xr, xw, xk, xv, xa, xg = [h + xx * mu[i] for i in range(6)]
    r = xr @ w_rkv[0]
    k = xk @ w_rkv[1]
    v = xv @ w_rkv[2]
    w_log = -jax.nn.softplus(-(w0 + jnp.tanh(xw @ wd_a) @ wd_b)) - 0.5
    decay = jnp.exp(-jnp.exp(w_log.astype(f32)))
    a = jax.nn.sigmoid((a0 + (xa @ wa_a) @ wa_b).astype(f32))
    g = jax.nn.sigmoid(xg @ wg_a) @ wg_b

    def heads(z):
        return z.reshape(B, S, H, N).astype(f32)

    r_h, v_h, w_h, a_h, k_h = heads(r), heads(v), heads(decay), heads(a), heads(k)
    kk = k_h * k_k.reshape(H, N).astype(f32)
    kk = kk * lax.rsqrt(jnp.maximum(jnp.sum(kk * kk, axis=-1, keepdims=True), 1e-24))
    k_h = k_h * (1 + (a_h - 1) * k_a.reshape(H, N).astype(f32))

    def step(state, inp):
        r_t, w_t, k_t, v_t, kk_t, a_t = inp
        sa = jnp.einsum('bhij,bhj->bhi', state, -kk_t)
        state = (state * w_t[:, :, None, :] + sa[..., None] * (kk_t * a_t)[:, :, None, :]
                 + v_t[..., None] * k_t[:, :, None, :])
        return state, jnp.einsum('bhij,bhj->bhi', state, r_t)

    xs = tuple(z.transpose(1, 0, 2, 3) for z in (r_h, w_h, k_h, v_h, kk, a_h))
    _, y = lax.scan(step, jnp.zeros((B, H, N, N), f32), xs)
    y = y.transpose(1, 0, 2, 3)
    mean = jnp.mean(y, axis=-1, keepdims=True)
    var = jnp.mean(jnp.square(y - mean), axis=-1, keepdims=True)
    y = ((y - mean) * lax.rsqrt(var + RWKV_GN_EPS)).reshape(B, S, D) * ln_w + ln_b
    y = y + (jnp.sum(r_h * k_h * r_k.astype(f32), axis=-1, keepdims=True) * v_h).reshape(B, S, D)
    return (y * g) @ w_out


def pool_mixer(h, w_grp, b, scale):
    B, S, D = h.shape
    hf = h.astype(jnp.float32)
    cs = jnp.pad(jnp.cumsum(hf, axis=1), ((0, 0), (1, 0), (0, 0)))
    t1 = jnp.arange(1, S + 1)
    groups = []
    for gi, win in enumerate(POOL_WINDOWS):
        csg = cs[:, :, gi * POOL_GROUP_DIM:(gi + 1) * POOL_GROUP_DIM]
        lo = jnp.maximum(t1 - win, 0)
        groups.append((csg[:, 1:] - csg[:, lo]) / (t1 - lo).astype(jnp.float32)[None, :, None])
    pooled = jnp.concatenate(groups, axis=-1) - hf
    y = jnp.einsum('bsgi,gio->bsgo', pooled.reshape(B, S, POOL_GROUPS, POOL_GROUP_DIM), w_grp).reshape(B, S, D) + b
    return y * scale


def setup_inputs(seed: int = 0) -> dict:
    key = jax.random.key(seed)
    ks = iter(jax.random.split(key, 40))
    D, F = D_MODEL, FFN_HIDDEN

    def nrm(shape, scale):
        return jax.random.normal(next(ks), shape, jnp.float32) * scale

    return {
        "x": nrm((BATCH, SEQ, D), 1.0),
        "c": nrm((BATCH, D), 1.0),
        "ada_w": nrm((DEPTH, D, N_MOD * D), 0.5 * D ** -0.5),
        "ada_b": nrm((DEPTH, N_MOD * D), 0.02),
        "norm_mix_w": 1.0 + nrm((DEPTH, D), 0.02),
        "norm_ffn_w": 1.0 + nrm((DEPTH, D), 0.02),
        "ffn_w_gate": nrm((DEPTH, D, F), D ** -0.5),
        "ffn_w_up": nrm((DEPTH, D, F), D ** -0.5),
        "ffn_w_down": nrm((DEPTH, F, D), F ** -0.5),
        "nsa_w_in": nrm((N_LAYERS_A, D, NSA_IN), D ** -0.5),
        "nsa_cmp_pos": nrm((N_LAYERS_A, 2, CMP_LEN, NSA_HEAD_DIM), 0.1),
        "nsa_cmp_w1": nrm((N_LAYERS_A, 2, CMP_LEN * NSA_HEAD_DIM, CMP_HIDDEN), (CMP_LEN * NSA_HEAD_DIM) ** -0.5),
        "nsa_cmp_w2": nrm((N_LAYERS_A, 2, CMP_HIDDEN, NSA_HEAD_DIM), CMP_HIDDEN ** -0.5),
        "nsa_qk_norm": 1.0 + nrm((N_LAYERS_A, 4, NSA_HEAD_DIM), 0.02),
        "nsa_w_out": nrm((N_LAYERS_A, NSA_HEADS * NSA_HEAD_DIM, D), D ** -0.5),
        "rwkv_mu": jax.random.uniform(next(ks), (N_LAYERS_B, 6, D), jnp.float32),
        "rwkv_w_rkv": nrm((N_LAYERS_B, 3, D, D), D ** -0.5),
        "rwkv_w0": nrm((N_LAYERS_B, D), 0.5),
        "rwkv_wd_a": nrm((N_LAYERS_B, D, DECAY_LORA), D ** -0.5),
        "rwkv_wd_b": nrm((N_LAYERS_B, DECAY_LORA, D), 0.5 * DECAY_LORA ** -0.5),
        "rwkv_a0": nrm((N_LAYERS_B, D), 0.5),
        "rwkv_wa_a": nrm((N_LAYERS_B, D, AAA_LORA), D ** -0.5),
        "rwkv_wa_b": nrm((N_LAYERS_B, AAA_LORA, D), 0.5 * AAA_LORA ** -0.5),
        "rwkv_wg_a": nrm((N_LAYERS_B, D, GATE_LORA), D ** -0.5),
        "rwkv_wg_b": nrm((N_LAYERS_B, GATE_LORA, D), GATE_LORA ** -0.5),
        "rwkv_k_k": 0.85 + nrm((N_LAYERS_B, D), 0.02),
        "rwkv_k_a": 1.0 + nrm((N_LAYERS_B, D), 0.02),
        "rwkv_r_k": nrm((N_LAYERS_B, RWKV_HEADS, RWKV_HEAD_DIM), 0.1),
        "rwkv_ln_w": 1.0 + nrm((N_LAYERS_B, D), 0.02),
        "rwkv_ln_b": nrm((N_LAYERS_B, D), 0.02),
        "rwkv_w_out": nrm((N_LAYERS_B, D, D), D ** -0.5),
        "pool_w": nrm((N_LAYERS_C, POOL_GROUPS, POOL_GROUP_DIM, POOL_GROUP_DIM), POOL_GROUP_DIM ** -0.5),
        "pool_b": nrm((N_LAYERS_C, D), 0.02),
        "pool_scale": 0.5 + nrm((N_LAYERS_C, D), 0.1),
    }


def reference(x, c, ada_w, ada_b, norm_mix_w, norm_ffn_w, ffn_w_gate, ffn_w_up, ffn_w_down,
              nsa_w_in, nsa_cmp_pos, nsa_cmp_w1, nsa_cmp_w2, nsa_qk_norm, nsa_w_out,
              rwkv_mu, rwkv_w_rkv, rwkv_w0, rwkv_wd_a, rwkv_wd_b, rwkv_a0, rwkv_wa_a, rwkv_wa_b,
              rwkv_wg_a, rwkv_wg_b, rwkv_k_k, rwkv_k_a, rwkv_r_k, rwkv_ln_w, rwkv_ln_b, rwkv_w_out,
              pool_w, pool_b, pool_scale):
    c_act = jax.nn.silu(c)
    for i in range(DEPTH):
        mod = c_act @ ada_w[i] + ada_b[i]
        sh_m, sc_m, g_m, sh_f, sc_f, g_f = jnp.split(mod, N_MOD, axis=-1)
        h = modulate(rms_norm(x, norm_mix_w[i]), sh_m, sc_m)
        kind, j = i % N_MIXERS, i // N_MIXERS
        if kind == 0:
            y = nsa_mixer(h, nsa_w_in[j], nsa_cmp_pos[j], nsa_cmp_w1[j], nsa_cmp_w2[j], nsa_qk_norm[j], nsa_w_out[j])
        elif kind == 1:
            y = rwkv7_mixer(h, rwkv_mu[j], rwkv_w_rkv[j], rwkv_w0[j], rwkv_wd_a[j], rwkv_wd_b[j], rwkv_a0[j],
                            rwkv_wa_a[j], rwkv_wa_b[j], rwkv_wg_a[j], rwkv_wg_b[j], rwkv_k_k[j], rwkv_k_a[j],
                            rwkv_r_k[j], rwkv_ln_w[j], rwkv_ln_b[j], rwkv_w_out[j])
        else:
            y = pool_mixer(h, pool_w[j], pool_b[j], pool_scale[j])
        x = x + (g_m[:, None, :] * y).astype(x.dtype)
        h = modulate(rms_norm(x, norm_ffn_w[i]), sh_f, sc_f)
        x = x + (g_f[:, None, :] * swiglu(h, ffn_w_gate[i], ffn_w_up[i], ffn_w_down[i])).astype(x.dtype)
    return x
```

```cpp
#include <hip/hip_runtime.h>
#include <hip/hip_cooperative_groups.h>
#include <cstdio>
#include <cstdint>
namespace cg = cooperative_groups;

#define DI __device__ __forceinline__
#define LAS __attribute__((address_space(3)))
typedef unsigned short bf16_t;
typedef short bf16x8 __attribute__((ext_vector_type(8)));
typedef float f32x2 __attribute__((ext_vector_type(2)));
typedef float f32x4 __attribute__((ext_vector_type(4)));
typedef float f32x16 __attribute__((ext_vector_type(16)));
typedef unsigned u32x2 __attribute__((ext_vector_type(2)));
typedef unsigned u32x4 __attribute__((ext_vector_type(4)));
typedef __bf16 bf16x2_t __attribute__((ext_vector_type(2)));

constexpr int SEQ = 8192, DM = 1024, MTOK = 16384, FF = 2816;
constexpr int NSA_IN = 2608, NSA_INP = 2816;
constexpr float LOG2E = 1.4426950408889634f;
constexpr float QSCALE = 0.125f * LOG2E;
constexpr float RMS_EPS = 1e-6f;

constexpr size_t MiB = 1u << 20;
constexpr size_t WS_MOD = 0;
constexpr size_t WS_PBIAS = 256 * 1024;
constexpr size_t WS_BAR = 512 * 1024;
constexpr size_t WS_W = 1 * MiB;
constexpr size_t SZ_NSA_IN = (size_t)NSA_INP * 1024 * 2, SZ_SQ = (size_t)1024 * 1024 * 2, SZ_CMP1 = (size_t)256 * 2048 * 2;
constexpr size_t SZ_GU = (size_t)2 * FF * 1024 * 2, SZ_DN = (size_t)1024 * FF * 2, SZ_RIN = (size_t)3328 * 2048 * 2, SZ_L2 = (size_t)3072 * 256 * 2, SZ_POOL = (size_t)1024 * 256 * 2;
constexpr size_t W_NSA_IN = WS_W, W_NSA_OUT = W_NSA_IN + 2 * SZ_NSA_IN, W_CMP1 = W_NSA_OUT + 2 * SZ_SQ, W_GU = W_CMP1 + 2 * SZ_CMP1, W_DN = W_GU + 4 * SZ_GU,
                 W_RIN = W_DN + 4 * SZ_DN, W_L2 = W_RIN + SZ_RIN, W_ROUT = W_L2 + SZ_L2, W_POOL = W_ROUT + SZ_SQ, W_END = W_POOL + SZ_POOL;
static_assert(W_END == 101 * MiB, "weights");
constexpr size_t WS_HB = 101 * MiB;
constexpr size_t WS_R = 136 * MiB;
constexpr size_t R_Q = WS_R, R_KCV = WS_R + 32 * MiB, R_KS = WS_R + 50 * MiB, R_VS = WS_R + 58 * MiB, R_KW = WS_R + 66 * MiB, R_VW = WS_R + 74 * MiB,
                 R_GATES = WS_R + 82 * MiB, R_CMPH = WS_R + 128 * MiB  , R_KCMP = WS_R + 90 * MiB, R_VCMP = WS_R + 91 * MiB, R_O = WS_R + 92 * MiB;
constexpr size_t R_ACT = WS_R;
constexpr size_t R_RKV = WS_R, R_LORAH = WS_R + 96 * MiB, R_WAG = WS_R + 104 * MiB, R_Y = WS_R + 200 * MiB;
constexpr size_t R_POOLED = WS_R;
constexpr size_t WS_END = WS_R + 232 * MiB;

constexpr int LDS_BYTES = 143360;

#ifndef PH
#define PH 0xFFFF
#endif
#ifndef DUP
#define DUP 0
#endif
struct P { const float* in[34]; float* out; unsigned char* ws; };

extern __shared__ __attribute__((aligned(16))) unsigned char lds_raw[];
constexpr int WAVEMAP_OFF = 143360 - 16 - 256;
DI unsigned hw_wave_key() { return (unsigned)__builtin_amdgcn_s_getreg((5 << 11) | 4) & 63u; }
DI int TID() {
    const int w = __builtin_amdgcn_readfirstlane(((volatile LAS int*)((LAS unsigned char*)lds_raw + WAVEMAP_OFF))[hw_wave_key()]);
    unsigned z = 0u; asm volatile("" : "+v"(z));
    int t = w * 64 + (int)__builtin_amdgcn_mbcnt_hi(~0u, __builtin_amdgcn_mbcnt_lo(~0u, z));
    asm volatile("" : "+v"(t)); return t;
}
DI const float* INP(const P& p, int i) { asm volatile("" : "+s"(i)); return p.in[i]; }
DI unsigned char* WSP(const P& p, size_t off) { asm volatile("" : "+s"(off)); return p.ws + off; }
DI unsigned cvtpk(float lo, float hi) { f32x2 v = {lo, hi}; bf16x2_t b = __builtin_convertvector(v, bf16x2_t); return __builtin_bit_cast(unsigned, b); }
DI bf16_t f2bf(float f) { return (bf16_t)(cvtpk(f, 0.f) & 0xffffu); }
DI float bf2f(bf16_t u) { return __uint_as_float(((unsigned)u) << 16); }
DI float wave_sum(float v) {
#pragma unroll
    for (int o = 1; o < 64; o <<= 1) v += __shfl_xor(v, o);
    return v;
}
DI float sigmoidf_(float x) { return 1.f / (1.f + __expf(-x)); }
template <int CTRL> DI int dpp_i(int v) { return __builtin_amdgcn_update_dpp(0, v, CTRL, 0xf, 0xf, false); }
DI int crow(int r, int h) { return (r & 3) + 8 * (r >> 2) + 4 * h; }

namespace pg8 {
constexpr int BM = 256, BK = 64, HALF = 128, HTB = HALF * BK * 2, STAGE_BYTES = 8 * HTB, NXCD = 8, WGM = 8;
DI int lds_byte(int r, int c) { const int st = (r >> 4) * 2 + (c >> 5), rr = r & 15, cc = c & 31, ob = rr * 64 + cc * 2; return st * 1024 + (ob ^ (((ob >> 9) & 1) << 5)); }
DI void stage_rc(int b, int& R, int& C) { const int st = b / 1024, sb = b % 1024, swz = sb ^ (((sb >> 9) & 1) << 5); R = (st >> 1) * 16 + swz / 64; C = (st & 1) * 32 + (swz % 64) / 2; }
struct Unit { int pm, pn; };
struct Gemm { const bf16_t* A; const bf16_t* Bt; int M, N, K, lda; int a_extra; int a_pn; int ldb; int b_pn; };
struct StaticOrder {
    int nM, nN, nwg, G, c;
    DI void init(int M, int N, int G_, int c_) { nM = M / BM; nN = N / BM; nwg = nM * nN; G = G_; c = c_; }
    DI bool next(int i, Unit& u) const {
        const long L = (long)i * G + c; if (L >= nwg) return false;
        int wgid = (int)L; { const int q = nwg / NXCD, r = nwg % NXCD, xcd = wgid % NXCD, off = wgid / NXCD; wgid = (xcd < r ? xcd * (q + 1) : r * (q + 1) + (xcd - r) * q) + off; }
        const int nig = WGM * nN, gid = wgid / nig, fm = gid * WGM, gsz = (nM - fm) < WGM ? (nM - fm) : WGM;
        u.pm = fm + ((wgid % nig) % gsz); u.pn = (wgid % nig) / gsz; return true;
    }
};

template <class Epi>
DI void gemm_phase(LAS unsigned char* lds, const Gemm g, const StaticOrder& S, const Epi& E) {
    const int tid = TID(), wid = __builtin_amdgcn_readfirstlane(tid >> 6), lane = tid & 63, wr = wid >> 2, wc = wid & 3, fr = lane & 15, fq = lane >> 4;
    int K = g.K; asm volatile("" : "+s"(K)); const int nt = K / BK;
    unsigned voffA[2], voffB[2];
    const int ldb = g.ldb ? g.ldb : K;
#pragma unroll
    for (int i = 0; i < 2; ++i) { int R, C; stage_rc(tid * 16 + i * 8192, R, C); voffA[i] = (unsigned)(R * g.lda + C) * 2u; voffB[i] = (unsigned)(R * ldb + C) * 2u; }
    const size_t kstep = (size_t)(BK * 2);
    const size_t hstepA = (size_t)HALF * g.lda * 2, hstepB = (size_t)HALF * ldb * 2;
    const size_t tstepA = 2 * hstepA, tstepB = g.b_pn ? (size_t)g.b_pn : 2 * hstepB;
    const unsigned ldsw = (unsigned)wid * 1024u;
    const int aoff = lds_byte(wr * 64 + fr, fq * 8), boff = lds_byte(wc * 32 + fr, fq * 8);
#define PG8_SA(b, h) (((b) * 2 + (h)) * HTB)
#define PG8_SB(b, h) ((4 + (b) * 2 + (h)) * HTB)
#define PG8_STAGE(bufoff, gbase, voff) do { _Pragma("unroll") for (int _i = 0; _i < 2; ++_i) \
        __builtin_amdgcn_global_load_lds((const unsigned*)((const char*)(gbase) + (voff)[_i]), (LAS unsigned*)(lds + (bufoff) + ldsw + _i * 8192), 16, 0, 0); } while (0)
#define PG8_LDA(dst, b, h) do { _Pragma("unroll") for (int m = 0; m < 4; ++m) _Pragma("unroll") for (int k = 0; k < 2; ++k) dst[m][k] = *(const LAS bf16x8*)(lds + PG8_SA(b, h) + aoff + m * 2048 + k * 1024); } while (0)
#define PG8_LDB(dst, b, h) do { _Pragma("unroll") for (int n = 0; n < 2; ++n) _Pragma("unroll") for (int k = 0; k < 2; ++k) dst[n][k] = *(const LAS bf16x8*)(lds + PG8_SB(b, h) + boff + n * 2048 + k * 1024); } while (0)
#define PG8_MMA(ai, bj, At, Bt) do { __builtin_amdgcn_s_setprio(1); _Pragma("unroll") for (int m = 0; m < 4; ++m) _Pragma("unroll") for (int n = 0; n < 2; ++n) _Pragma("unroll") for (int k = 0; k < 2; ++k) \
        acc[ai][bj][m][n] = __builtin_amdgcn_mfma_f32_16x16x32_bf16(Bt[n][k], At[m][k], acc[ai][bj][m][n], 0, 0, 0); __builtin_amdgcn_s_setprio(0); } while (0)
#define PG8_WAIT_V(n) asm volatile("s_waitcnt vmcnt(" #n ")" ::: "memory")
#define PG8_WAIT_L(n) asm volatile("s_waitcnt lgkmcnt(" #n ")" ::: "memory")
#define PG8_BAR __builtin_amdgcn_s_barrier()
#define PG8_SCHED __builtin_amdgcn_sched_barrier(0)
#define PG8_AOF(u_) ((const char*)g.A + (size_t)(u_).pm * tstepA + (size_t)((u_).pm >> 5) * (size_t)g.a_extra + (size_t)(u_).pn * (size_t)g.a_pn)
    Unit cur, nxt; int ui = 0;
    if (!S.next(0, cur)) return;
    f32x4 acc[2][2][4][2];
#pragma unroll
    for (int a = 0; a < 2; ++a)
#pragma unroll
        for (int b = 0; b < 2; ++b)
#pragma unroll
            for (int m = 0; m < 4; ++m)
#pragma unroll
                for (int n = 0; n < 2; ++n) acc[a][b][m][n] = (f32x4){0.f, 0.f, 0.f, 0.f};
    bf16x8 At[4][2], B0[2][2], B1[2][2];
    const char* cA = PG8_AOF(cur); const char* cB = (const char*)g.Bt + (size_t)cur.pn * tstepB;
    PG8_STAGE(PG8_SB(0, 0), cB, voffB); PG8_STAGE(PG8_SB(0, 1), cB + hstepB, voffB); PG8_STAGE(PG8_SA(0, 0), cA, voffA); PG8_STAGE(PG8_SA(0, 1), cA + hstepA, voffA);
    if (wr == 1) PG8_BAR;
    PG8_WAIT_V(2); PG8_BAR;
    PG8_STAGE(PG8_SB(1, 0), cB + kstep, voffB); PG8_STAGE(PG8_SA(1, 0), cA + kstep, voffA); PG8_STAGE(PG8_SB(1, 1), cB + hstepB + kstep, voffB);
    PG8_WAIT_V(6); PG8_BAR;
    for (;;) {
        const bool has_next = S.next(ui + 1, nxt);
        const char* nA = has_next ? PG8_AOF(nxt) : cA; const char* nB = has_next ? (const char*)g.Bt + (size_t)nxt.pn * tstepB : cB;
        for (int t = 0; t < nt; t += 2) {
            const bool last = (t == nt - 2);
            const char* a1 = cA + (size_t)(t + 1) * kstep;
            const char* a2 = last ? nA : cA + (size_t)(t + 2) * kstep; const char* b2 = last ? nB : cB + (size_t)(t + 2) * kstep;
            const char* a3 = a2 + kstep; const char* b3 = b2 + kstep;
            PG8_LDB(B0, 0, 0); PG8_LDB(B1, 0, 1); PG8_SCHED; PG8_LDA(At, 0, 0); PG8_STAGE(PG8_SA(1, 1), a1 + hstepA, voffA);
            PG8_WAIT_V(8); PG8_WAIT_L(0); PG8_BAR; PG8_MMA(0, 0, At, B0); PG8_MMA(0, 1, At, B1); PG8_BAR; PG8_SCHED;
            PG8_LDA(At, 0, 1); PG8_STAGE(PG8_SB(0, 0), b2, voffB); PG8_STAGE(PG8_SB(0, 1), b2 + hstepB, voffB); PG8_STAGE(PG8_SA(0, 0), a2, voffA);
            PG8_WAIT_V(8); PG8_WAIT_L(0); PG8_BAR; PG8_MMA(1, 0, At, B0); PG8_MMA(1, 1, At, B1); PG8_BAR; PG8_SCHED;
            PG8_LDB(B0, 1, 0); PG8_LDB(B1, 1, 1); PG8_SCHED; PG8_LDA(At, 1, 0); PG8_STAGE(PG8_SA(0, 1), a2 + hstepA, voffA);
            PG8_WAIT_V(8); PG8_WAIT_L(0); PG8_BAR; PG8_MMA(0, 0, At, B0); PG8_MMA(0, 1, At, B1); PG8_BAR; PG8_SCHED;
            PG8_LDA(At, 1, 1); PG8_STAGE(PG8_SB(1, 0), b3, voffB); PG8_STAGE(PG8_SB(1, 1), b3 + hstepB, voffB); PG8_STAGE(PG8_SA(1, 0), a3, voffA);
            PG8_WAIT_V(8); PG8_WAIT_L(0); PG8_BAR; PG8_MMA(1, 0, At, B0); PG8_MMA(1, 1, At, B1); PG8_BAR; PG8_SCHED;
        }
        if (wr == 0) PG8_BAR;
        E(acc, cur, wr, wc, fr, fq);
        if (!has_next) break;
#pragma unroll
        for (int a = 0; a < 2; ++a)
#pragma unroll
            for (int b = 0; b < 2; ++b)
#pragma unroll
                for (int m = 0; m < 4; ++m)
#pragma unroll
                    for (int n = 0; n < 2; ++n) acc[a][b][m][n] = (f32x4){0.f, 0.f, 0.f, 0.f};
        cur = nxt; cA = nA; cB = nB; ++ui;
        if (wr == 1) PG8_BAR;
    }
    PG8_WAIT_V(0);
    PG8_BAR;
#undef PG8_SA
#undef PG8_SB
#undef PG8_STAGE
#undef PG8_LDA
#undef PG8_LDB
#undef PG8_MMA
#undef PG8_WAIT_V
#undef PG8_WAIT_L
#undef PG8_BAR
#undef PG8_SCHED
#undef PG8_AOF
}
}
using pg8::Unit;
typedef f32x4 AccT[2][2][4][2];

DI void st_bf4(bf16_t* p, f32x4 v) { u32x2 w; w.x = cvtpk(v[0], v[1]); w.y = cvtpk(v[2], v[3]); *(u32x2*)p = w; }

struct EpiRes {
    float* x; const float* gate; const float* bias; const float* pscale; const float* xin;
    DI void operator()(const AccT& acc, const Unit& u, int wr, int wc, int fr, int fq) const {
        const int b = u.pm >> 5; const float* gp = gate + b * 6144;
        const int colb = u.pn * 256 + wc * 64 + fq * 4;
        f32x4 g4[2][2], b4[2][2];
#pragma unroll
        for (int bj = 0; bj < 2; ++bj)
#pragma unroll
            for (int n = 0; n < 2; ++n) {
                const int col = colb + bj * 32 + n * 16;
                g4[bj][n] = *(const f32x4*)(gp + col);
                if (bias) { const f32x4 s4 = *(const f32x4*)(pscale + col); g4[bj][n] = g4[bj][n] * s4; b4[bj][n] = *(const f32x4*)(bias + col) * g4[bj][n]; }
                else b4[bj][n] = (f32x4){0.f, 0.f, 0.f, 0.f};
            }
#pragma unroll
        for (int ai = 0; ai < 2; ++ai)
#pragma unroll
            for (int mh = 0; mh < 2; ++mh) {
                f32x4 xv[2][2][2];
#pragma unroll
                for (int m2 = 0; m2 < 2; ++m2) { const float* xr = xin + (size_t)(u.pm * 256 + ai * 128 + wr * 64 + (mh * 2 + m2) * 16 + fr) * DM + colb;
#pragma unroll
                    for (int bj = 0; bj < 2; ++bj)
#pragma unroll
                        for (int n = 0; n < 2; ++n) xv[m2][bj][n] = *(const f32x4*)(xr + bj * 32 + n * 16); }
#pragma unroll
                for (int m2 = 0; m2 < 2; ++m2) { float* xr = x + (size_t)(u.pm * 256 + ai * 128 + wr * 64 + (mh * 2 + m2) * 16 + fr) * DM + colb;
#pragma unroll
                    for (int bj = 0; bj < 2; ++bj)
#pragma unroll
                        for (int n = 0; n < 2; ++n) *(f32x4*)(xr + bj * 32 + n * 16) = xv[m2][bj][n] + g4[bj][n] * acc[ai][bj][mh * 2 + m2][n] + b4[bj][n]; }
                asm volatile("" ::: "memory");
            }
    }
};
struct EpiFfnUp {
    bf16_t* act;
    DI void operator()(const AccT& acc, const Unit& u, int wr, int wc, int fr, int fq) const {
#pragma unroll
        for (int ai = 0; ai < 2; ++ai)
#pragma unroll
            for (int m = 0; m < 4; ++m) {
                const int row = u.pm * 256 + ai * 128 + wr * 64 + m * 16 + fr; bf16_t* ar = act + (size_t)row * FF;
#pragma unroll
                for (int bj = 0; bj < 2; ++bj) {
                    const f32x4 gt = acc[ai][bj][m][0], up = acc[ai][bj][m][1]; f32x4 o;
#pragma unroll
                    for (int j = 0; j < 4; ++j) o[j] = gt[j] * __builtin_amdgcn_rcpf(1.f + __builtin_amdgcn_exp2f(-gt[j] * LOG2E)) * up[j];
                    st_bf4(ar + 16 * (8 * u.pn + 2 * wc + bj) + 4 * fq, o);
                }
            }
    }
};
struct EpiNsaIn {
    bf16_t *Q, *KCV, *KS, *VS, *KW, *VW; float* GATES; const float* qkn;
    DI void operator()(const AccT& acc, const Unit& u, int wr, int wc, int fr, int fq) const {
        const int pn = u.pn, b = u.pm >> 5;
        if (pn >= 10) {
            if (pn > 10 || wc != 0) return;
#pragma unroll
            for (int ai = 0; ai < 2; ++ai)
#pragma unroll
                for (int m = 0; m < 4; ++m) {
                    const int row = u.pm * 256 + ai * 128 + wr * 64 + m * 16 + fr;
#pragma unroll
                    for (int bj = 0; bj < 2; ++bj)
#pragma unroll
                        for (int n = 0; n < 2; ++n) {
                            const int c = bj * 32 + n * 16 + fq * 4;
                            if (c < 48) { f32x4 v = acc[ai][bj][m][n]; f32x4 o;
#pragma unroll
                                for (int j = 0; j < 4; ++j) o[j] = sigmoidf_(v[j]);
                                *(f32x4*)(GATES + (size_t)row * 48 + c) = o; }
                        }
                }
            return;
        }
        const bool nrm = (pn < 4) || pn == 6 || pn == 8;
        const int nidx = pn < 4 ? 0 : (pn == 6 ? 2 : 3);
        const float osc = pn < 4 ? QSCALE : 1.f;
        bf16_t* base; size_t rs;
        if (pn < 4) { base = Q + (size_t)(b * SEQ) * DM + pn * 256 + wc * 64; rs = DM; }
        else { bf16_t* arr = pn == 4 ? KCV : pn == 5 ? KCV + (size_t)8 * 524288 : pn == 6 ? KS : pn == 7 ? VS : pn == 8 ? KW : VW; base = arr + (size_t)(b * 4 + wc) * 524288; rs = 64; }
        f32x4 qw[2][2];
#pragma unroll
        for (int bj = 0; bj < 2; ++bj)
#pragma unroll
            for (int n = 0; n < 2; ++n) qw[bj][n] = nrm ? *(const f32x4*)(qkn + nidx * 64 + bj * 32 + n * 16 + fq * 4) : (f32x4){1.f, 1.f, 1.f, 1.f};
#pragma unroll
        for (int ai = 0; ai < 2; ++ai)
#pragma unroll
            for (int m = 0; m < 4; ++m) {
                const int t = (u.pm & 31) * 256 + ai * 128 + wr * 64 + m * 16 + fr;
                float rstd = 1.f;
                if (nrm) {
                    float ss = 0.f;
#pragma unroll
                    for (int bj = 0; bj < 2; ++bj)
#pragma unroll
                        for (int n = 0; n < 2; ++n) { const f32x4 v = acc[ai][bj][m][n]; ss += (v[0] * v[0] + v[1] * v[1]) + (v[2] * v[2] + v[3] * v[3]); }
                    ss += __shfl_xor(ss, 16); ss += __shfl_xor(ss, 32);
                    rstd = rsqrtf(ss * (1.f / 64.f) + RMS_EPS) * osc;
                }
#pragma unroll
                for (int bj = 0; bj < 2; ++bj)
#pragma unroll
                    for (int n = 0; n < 2; ++n) {
                        const int d = bj * 32 + n * 16 + fq * 4; const f32x4 v = acc[ai][bj][m][n] * rstd * qw[bj][n];
                        st_bf4(base + (size_t)t * rs + d, v);
                    }
            }
    }
};
DI float gelu_tanh(float x) { const float u = 0.7978845608028654f * (x + 0.044715f * x * x * x); const float e = __expf(2.f * u); const float th = 1.f - 2.f / (e + 1.f); return 0.5f * x * (1.f + th); }
struct EpiCmp {
    float* PART;
    DI void operator()(const AccT& acc, const Unit& u, int wr, int wc, int fr, int fq) const {
        const int kv = u.pm >> 4;
        if ((wc >> 1) != kv) return;
        float* base = PART + (size_t)u.pn * 8192 * 128 + (wc & 1) * 64 + fq * 4;
#pragma unroll
        for (int ai = 0; ai < 2; ++ai)
#pragma unroll
            for (int m = 0; m < 4; ++m) {
                const int row = u.pm * 256 + ai * 128 + wr * 64 + m * 16 + fr;
#pragma unroll
                for (int bj = 0; bj < 2; ++bj)
#pragma unroll
                    for (int n = 0; n < 2; ++n) *(f32x4*)(base + (size_t)row * 128 + bj * 32 + n * 16) = acc[ai][bj][m][n];
            }
    }
};
struct EpiRwkvIn {
    bf16_t* RKV; bf16_t* LORAH;
    DI void operator()(const AccT& acc, const Unit& u, int wr, int wc, int fr, int fq) const {
        const int pn = u.pn;
        if (pn < 12) {
            bf16_t* base = RKV + (size_t)(pn >> 2) * MTOK * DM + (pn & 3) * 256 + wc * 64 + fq * 4;
#pragma unroll
            for (int ai = 0; ai < 2; ++ai)
#pragma unroll
                for (int m = 0; m < 4; ++m) {
                    const int row = u.pm * 256 + ai * 128 + wr * 64 + m * 16 + fr;
#pragma unroll
                    for (int bj = 0; bj < 2; ++bj)
#pragma unroll
                        for (int n = 0; n < 2; ++n) st_bf4(base + (size_t)row * DM + bj * 32 + n * 16, acc[ai][bj][m][n]);
                }
        } else {
            bf16_t* base = LORAH + wc * 64 + fq * 4;
#pragma unroll
            for (int ai = 0; ai < 2; ++ai)
#pragma unroll
                for (int m = 0; m < 4; ++m) {
                    const int row = u.pm * 256 + ai * 128 + wr * 64 + m * 16 + fr;
#pragma unroll
                    for (int bj = 0; bj < 2; ++bj)
#pragma unroll
                        for (int n = 0; n < 2; ++n) { const f32x4 v = acc[ai][bj][m][n]; f32x4 o;
#pragma unroll
                            for (int j = 0; j < 4; ++j) { const float z = v[j]; const float sg = __builtin_amdgcn_rcpf(1.f + __builtin_amdgcn_exp2f(-z * (wc == 0 ? 2.f * LOG2E : LOG2E))); o[j] = wc == 0 ? (2.f * sg - 1.f) : (wc == 1 ? z : sg); }
                            st_bf4(base + (size_t)row * 256 + bj * 32 + n * 16, o); }
                    asm volatile("" ::: "memory");
                }
        }
    }
};
struct EpiLora2 {
    bf16_t* WAG; const float* w0; const float* a0;
    DI void operator()(const AccT& acc, const Unit& u, int wr, int wc, int fr, int fq) const {
        const int pn = u.pn, which = pn >> 2;
        const int colb = (pn & 3) * 256 + wc * 64 + fq * 4;
        bf16_t* base = WAG + (size_t)which * MTOK * DM + colb;
        const float* addp = which == 0 ? w0 : a0;
        const float osc = which == 0 ? 0.6065306597126334f : 1.f;
        f32x4 ad[2][2];
#pragma unroll
        for (int bj = 0; bj < 2; ++bj)
#pragma unroll
            for (int n = 0; n < 2; ++n) ad[bj][n] = which < 2 ? *(const f32x4*)(addp + colb + bj * 32 + n * 16) : (f32x4){0.f, 0.f, 0.f, 0.f};
#pragma unroll
        for (int ai = 0; ai < 2; ++ai)
#pragma unroll
            for (int m = 0; m < 4; ++m) {
                const int row = u.pm * 256 + ai * 128 + wr * 64 + m * 16 + fr;
#pragma unroll
                for (int bj = 0; bj < 2; ++bj)
#pragma unroll
                    for (int n = 0; n < 2; ++n) {
                        f32x4 v = acc[ai][bj][m][n]; f32x4 o;
                        if (which < 2) { const f32x4 a4 = ad[bj][n];
#pragma unroll
                            for (int j = 0; j < 4; ++j) o[j] = osc * __builtin_amdgcn_rcpf(1.f + __builtin_amdgcn_exp2f(-(v[j] + a4[j]) * LOG2E)); }
                        else o = v;
                        st_bf4(base + (size_t)row * DM + bj * 32 + n * 16, o);
                    }
                asm volatile("" ::: "memory");
            }
    }
};

DI float wsrc(const P& p, int id, int k, int c) {
    if (id < 2) { const float* W = p.in[9] + (size_t)id * 1024 * NSA_IN; return c < NSA_IN ? W[(size_t)k * NSA_IN + c] : 0.f; }
    if (id < 4) { const float* W = p.in[14] + (size_t)(id - 2) * 1024 * 1024; return W[(size_t)k * 1024 + c]; }
    if (id < 6) { const int kv = c >> 7; const float* W = p.in[11] + (size_t)((id - 4) * 2 + kv) * 2048 * 128; return W[(size_t)k * 128 + (c & 127)]; }
    if (id < 10) { const int grp = c >> 5, w = c & 31, col = grp * 16 + (w & 15); const float* W = ((w >> 4) ? p.in[7] : p.in[6]) + (size_t)(id - 6) * 1024 * FF; return W[(size_t)k * FF + col]; }
    if (id < 14) { const float* W = p.in[8] + (size_t)(id - 10) * FF * 1024; return W[(size_t)k * 1024 + c]; }
    if (id == 14) {
        const int kk = k & 1023; const bool prev = k < 1024; int mi, ldw, cc; const float* W;
        if (c < 3072) { const int which = c >> 10; mi = which == 0 ? 0 : (which == 1 ? 2 : 3); W = p.in[16] + (size_t)which * 1024 * 1024; ldw = 1024; cc = c & 1023; }
        else if (c < 3136) { mi = 1; W = p.in[18]; ldw = 64; cc = c - 3072; }
        else if (c < 3200) { mi = 4; W = p.in[21]; ldw = 64; cc = c - 3136; }
        else { mi = 5; W = p.in[23]; ldw = 128; cc = c - 3200; }
        const float mu = p.in[15][mi * 1024 + kk], w = W[(size_t)kk * ldw + cc];
        return prev ? mu * w : (1.f - mu) * w;
    }
    if (id == 15) {
        if (c < 1024) return k < 64 ? p.in[19][(size_t)k * 1024 + c] : 0.f;
        if (c < 2048) return (k >= 64 && k < 128) ? p.in[22][(size_t)(k - 64) * 1024 + (c - 1024)] : 0.f;
        return k >= 128 ? p.in[24][(size_t)(k - 128) * 1024 + (c - 2048)] : 0.f;
    }
    if (id == 16) return p.in[30][(size_t)k * 1024 + c];
    return p.in[31][(size_t)((c >> 8) * 256 + k) * 256 + (c & 255)];
}
DI void mat_info(int id, int& N, int& K, size_t& off) {
    if (id < 2) { N = NSA_INP; K = 1024; off = W_NSA_IN + id * SZ_NSA_IN; }
    else if (id < 4) { N = 1024; K = 1024; off = W_NSA_OUT + (id - 2) * SZ_SQ; }
    else if (id < 6) { N = 256; K = 2048; off = W_CMP1 + (id - 4) * SZ_CMP1; }
    else if (id < 10) { N = 2 * FF; K = 1024; off = W_GU + (id - 6) * SZ_GU; }
    else if (id < 14) { N = 1024; K = FF; off = W_DN + (id - 10) * SZ_DN; }
    else if (id == 14) { N = 3328; K = 2048; off = W_RIN; }
    else if (id == 15) { N = 3072; K = 256; off = W_L2; }
    else if (id == 16) { N = 1024; K = 1024; off = W_ROUT; }
    else { N = 1024; K = 256; off = W_POOL; }
}
struct ItemSrc { const float* lp; size_t step; const float* mup; bool valid, prev; };
DI ItemSrc item_src(const P& p, int id, int k0, int c0, int lane) {
    ItemSrc it; it.mup = nullptr; it.valid = true; it.prev = false;
    const int c = c0 + lane;
    const float* W; int ldw, col, krow = k0;
    if (id < 2) { W = p.in[9] + (size_t)id * 1024 * NSA_IN; ldw = NSA_IN; col = c; it.valid = c < NSA_IN; }
    else if (id < 4) { W = p.in[14] + (size_t)(id - 2) * 1024 * 1024; ldw = 1024; col = c; }
    else if (id < 6) { W = p.in[11] + (size_t)((id - 4) * 2 + (c >> 7)) * 2048 * 128; ldw = 128; col = c & 127; }
    else if (id < 10) { const int w = c & 31; W = ((w >> 4) ? p.in[7] : p.in[6]) + (size_t)(id - 6) * 1024 * FF; ldw = FF; col = (c >> 5) * 16 + (w & 15); }
    else if (id < 14) { W = p.in[8] + (size_t)(id - 10) * FF * 1024; ldw = 1024; col = c; }
    else if (id == 14) {
        int mi; krow = k0 & 1023; it.prev = k0 < 1024;
        if (c < 3072) { const int which = c >> 10; mi = which == 0 ? 0 : (which == 1 ? 2 : 3); W = p.in[16] + (size_t)which * 1024 * 1024; ldw = 1024; col = c & 1023; }
        else if (c < 3136) { mi = 1; W = p.in[18]; ldw = 64; col = c - 3072; }
        else if (c < 3200) { mi = 4; W = p.in[21]; ldw = 64; col = c - 3136; }
        else { mi = 5; W = p.in[23]; ldw = 128; col = c - 3200; }
        it.mup = p.in[15] + mi * 1024 + krow;
    }
    else if (id == 15) {
        if (c < 1024) { W = p.in[19]; col = c; it.valid = k0 < 64; }
        else if (c < 2048) { W = p.in[22]; col = c - 1024; krow = k0 - 64; it.valid = (k0 >= 64 && k0 < 128); }
        else { W = p.in[24]; col = c - 2048; krow = k0 - 128; it.valid = k0 >= 128; }
        ldw = 1024;
    }
    else if (id == 16) { W = p.in[30]; ldw = 1024; col = c; }
    else { W = p.in[31] + (size_t)(c >> 8) * 65536; ldw = 256; col = c & 255; }
    if (!it.valid) { krow = 0; col = 0; }
    it.lp = W + (size_t)krow * ldw + col; it.step = (size_t)ldw;
    return it;
}
DI void convert_weights(const P& p, LAS unsigned char* lds, unsigned mask, int gw, int NGW, int wave, int lane) {
    LAS float* scr = (LAS float*)(lds + wave * 16896);
    int base = 0;
    for (int id = 0; id < 18; ++id) {
        if (!((mask >> id) & 1u)) continue;
        int N, K; size_t off; mat_info(id, N, K, off);
        const int nblk = N / 64, nitems = (K / 64) * nblk;
        bf16_t* WT = (bf16_t*)(p.ws + off);
        int first = (gw - base % NGW + NGW) % NGW;
        for (int r = first; r < nitems; r += NGW) {
            const int kb = r / nblk, nb = r % nblk, k0 = 64 * kb, tile = nb >> 2, wc = nb & 3;
            const int c0 = 256 * tile + 64 * wc, d0 = 256 * tile + 32 * wc;
            const ItemSrc it = item_src(p, id, k0, c0, lane);
#pragma unroll
            for (int h2 = 0; h2 < 2; ++h2) {
                float tv[32];
#pragma unroll
                for (int i = 0; i < 32; ++i) tv[i] = it.lp[(size_t)(32 * h2 + i) * it.step];
                if (it.mup) {
#pragma unroll
                    for (int i = 0; i < 32; ++i) { const float m = it.mup[32 * h2 + i]; tv[i] *= it.prev ? m : 1.f - m; }
                }
#pragma unroll
                for (int i = 0; i < 32; ++i) scr[(32 * h2 + i) * 65 + lane] = it.valid ? tv[i] : 0.f;
            }
            asm volatile("s_waitcnt lgkmcnt(0)" ::: "memory");
#pragma unroll
            for (int j = 0; j < 8; ++j) { const int cid = lane + 64 * j, n = cid >> 3, cch = cid & 7; const LAS float* sp = scr + (8 * cch) * 65 + n;
                u32x4 o; o.x = cvtpk(sp[0 * 65], sp[1 * 65]); o.y = cvtpk(sp[2 * 65], sp[3 * 65]); o.z = cvtpk(sp[4 * 65], sp[5 * 65]); o.w = cvtpk(sp[6 * 65], sp[7 * 65]);
                *(u32x4*)(WT + (size_t)(d0 + (n & 31) + 128 * (n >> 5)) * K + k0 + 8 * cch) = o; }
            asm volatile("s_waitcnt lgkmcnt(0)" ::: "memory");
        }
        base += nitems;
    }
}
DI void p0_phase(const P& p, LAS unsigned char* lds) {
    const int tid = threadIdx.x, lane = tid & 63, wave = tid >> 6, bi = blockIdx.x;
    LAS float* fl = (LAS float*)lds;
    if (bi < 96) {
        const int layer = bi / 24, n0 = (bi % 24) * 256;
        LAS float* cact = fl; LAS float* red = fl + 2048;
        for (int i = tid; i < 2048; i += 512) { const float cv = p.in[1][i]; cact[i] = cv / (1.f + __expf(-cv)); }
        __syncthreads();
        f32x4 a0 = {0.f, 0.f, 0.f, 0.f}, a1 = a0;
        const float* Wb = p.in[2] + ((size_t)layer * 1024 + wave * 128) * 6144 + n0 + 4 * lane;
        for (int kb = 0; kb < 128; kb += 32) {
            f32x4 wv[32];
#pragma unroll
            for (int k = 0; k < 32; ++k) wv[k] = *(const f32x4*)(Wb + (size_t)(kb + k) * 6144);
#pragma unroll
            for (int k = 0; k < 32; ++k) { const float c0 = cact[wave * 128 + kb + k], c1 = cact[1024 + wave * 128 + kb + k]; a0 += wv[k] * c0; a1 += wv[k] * c1; }
        }
#pragma unroll
        for (int e = 0; e < 4; ++e) { red[(wave * 2 + 0) * 256 + 4 * lane + e] = a0[e]; red[(wave * 2 + 1) * 256 + 4 * lane + e] = a1[e]; }
        __syncthreads();
        { const int b = tid >> 8, col = tid & 255; float s = 0.f;
#pragma unroll
          for (int w = 0; w < 8; ++w) s += red[(w * 2 + b) * 256 + col];
          ((float*)(p.ws + WS_MOD))[(size_t)(layer * 2 + b) * 6144 + n0 + col] = s + p.in[3][(size_t)layer * 6144 + n0 + col]; }
        __syncthreads();
    } else if (bi < 100) {
        const int it = bi - 96; const float* pos = p.in[10] + (size_t)it * 2048; const float* w1 = p.in[11] + (size_t)it * 2048 * 128;
        const int c = tid & 127, ks = tid >> 7; float s = 0.f;
        for (int kb = ks * 512; kb < ks * 512 + 512; kb += 32) {
            float wv[32];
#pragma unroll
            for (int k = 0; k < 32; ++k) wv[k] = w1[(size_t)(kb + k) * 128 + c];
#pragma unroll
            for (int k = 0; k < 32; ++k) s += pos[kb + k] * wv[k];
        }
        fl[ks * 128 + c] = s; __syncthreads();
        if (tid < 128) ((float*)(p.ws + WS_PBIAS))[it * 128 + tid] = (fl[tid] + fl[128 + tid]) + (fl[256 + tid] + fl[384 + tid]);
        __syncthreads();
    } else if (bi == 100) {
        unsigned* hb = (unsigned*)(p.ws + WS_HB);
        hb[tid] = 0u; hb[(size_t)8193 * 512 + tid] = 0u;
    }
    convert_weights(p, lds, 0x3FFFFu, bi * 8 + wave, gridDim.x * 8, wave, lane);
}

DI void norm_phase(const float* xs, float* xcopy, bf16_t* HB, const float* nw, const float* shift, const float* scale) {
    const int tid_ = TID(), lane = tid_ & 63, gw = blockIdx.x * 8 + (tid_ >> 6), NGW = gridDim.x * 8;
    f32x4 w4[4];
#pragma unroll
    for (int j = 0; j < 4; ++j) w4[j] = *(const f32x4*)(nw + 4 * lane + 256 * j);
    for (int m = gw; m < MTOK; m += 2 * NGW) {
        const int m1 = m + NGW;
        const bool has1 = m1 < MTOK;
        const f32x4* xr0 = (const f32x4*)(xs + (size_t)m * DM) + lane;
        const f32x4* xr1 = (const f32x4*)(xs + (size_t)(has1 ? m1 : m) * DM) + lane;
        f32x4 v0[4], v1[4];
#pragma unroll
        for (int j = 0; j < 4; ++j) v0[j] = xr0[64 * j];
#pragma unroll
        for (int j = 0; j < 4; ++j) v1[j] = xr1[64 * j];
        float ss0 = 0.f, ss1 = 0.f;
#pragma unroll
        for (int j = 0; j < 4; ++j) { ss0 += (v0[j][0] * v0[j][0] + v0[j][1] * v0[j][1]) + (v0[j][2] * v0[j][2] + v0[j][3] * v0[j][3]);
                                      ss1 += (v1[j][0] * v1[j][0] + v1[j][1] * v1[j][1]) + (v1[j][2] * v1[j][2] + v1[j][3] * v1[j][3]); }
#pragma unroll
        for (int o = 1; o < 64; o <<= 1) { ss0 += __shfl_xor(ss0, o); ss1 += __shfl_xor(ss1, o); }
        const float rstd0 = rsqrtf(ss0 * (1.f / DM) + RMS_EPS), rstd1 = rsqrtf(ss1 * (1.f / DM) + RMS_EPS);
        if (xcopy) { f32x4* xo = (f32x4*)(xcopy + (size_t)m * DM) + lane;
#pragma unroll
            for (int j = 0; j < 4; ++j) xo[64 * j] = v0[j];
            if (has1) { f32x4* xo1 = (f32x4*)(xcopy + (size_t)m1 * DM) + lane;
#pragma unroll
                for (int j = 0; j < 4; ++j) xo1[64 * j] = v1[j]; } }
        { const int b = m >> 13; bf16_t* ho = HB + (size_t)(m + 1 + b) * DM;
#pragma unroll
          for (int j = 0; j < 4; ++j) { const int col = 4 * lane + 256 * j;
              const f32x4 sc4 = *(const f32x4*)(scale + b * 6144 + col), sh4 = *(const f32x4*)(shift + b * 6144 + col);
              st_bf4(ho + col, (v0[j] * rstd0) * w4[j] * (sc4 + 1.f) + sh4); } }
        if (has1) { const int b = m1 >> 13; bf16_t* ho = HB + (size_t)(m1 + 1 + b) * DM;
#pragma unroll
          for (int j = 0; j < 4; ++j) { const int col = 4 * lane + 256 * j;
              const f32x4 sc4 = *(const f32x4*)(scale + b * 6144 + col), sh4 = *(const f32x4*)(shift + b * 6144 + col);
              st_bf4(ho + col, (v1[j] * rstd1) * w4[j] * (sc4 + 1.f) + sh4); } }
    }
}

DI void cmp2_phase(const P& p, int j, LAS unsigned char* lds) {
    const int tid_ = TID(), lane = tid_ & 63, wave = tid_ >> 6, gw = blockIdx.x * 8 + wave, NGW = gridDim.x * 8;
    const float* CMPH = (const float*)(WSP(p, R_CMPH));
    const float* pbp = (const float*)(WSP(p, WS_PBIAS)) + j * 256;
    const float* w2b = INP(p, 12) + (size_t)(j * 2) * 128 * 64; const float* qn1 = INP(p, 13) + (size_t)(j * 4 + 1) * 64;
    bf16_t* KCo = (bf16_t*)(WSP(p, R_KCMP)); bf16_t* VCo = (bf16_t*)(WSP(p, R_VCMP));
    LAS float* w2s = (LAS float*)lds;
    LAS float* hrow = (LAS float*)(lds + 65536) + wave * 128;
    for (int e = tid_; e < 2 * 128 * 64; e += 512) w2s[e] = w2b[e];
    __syncthreads();
    for (int row = gw; row < 8192; row += NGW) {
        const int slab = row >> 9, n = row & 511, kv = slab >> 3;
        f32x2 hp[8];
#pragma unroll
        for (int ks = 0; ks < 8; ++ks) hp[ks] = *(const f32x2*)(CMPH + (size_t)ks * 8192 * 128 + (size_t)row * 128 + 2 * lane);
        f32x2 h2 = *(const f32x2*)(pbp + kv * 128 + 2 * lane);
#pragma unroll
        for (int ks = 0; ks < 8; ++ks) h2 = h2 + hp[ks];
        hrow[2 * lane] = gelu_tanh(h2[0]); hrow[2 * lane + 1] = gelu_tanh(h2[1]);
        asm volatile("s_waitcnt lgkmcnt(0)" ::: "memory");
        const LAS float* w2 = w2s + kv * 8192 + lane;
        float a0 = 0.f, a1 = 0.f;
#pragma unroll 16
        for (int c = 0; c < 128; c += 2) { a0 += hrow[c] * w2[c * 64]; a1 += hrow[c + 1] * w2[(c + 1) * 64]; }
        const float acc = a0 + a1;
        float o = acc;
        if (kv == 0) { const float ss = wave_sum(acc * acc); o = acc * rsqrtf(ss * (1.f / 64.f) + RMS_EPS) * qn1[lane]; }
        if (n == 511) o = 0.f;
        bf16_t* dst = (kv == 0 ? KCo : VCo) + (size_t)(slab & 7) * 512 * 64 + (size_t)n * 64 + lane;
        *dst = f2bf(o);
        asm volatile("s_waitcnt lgkmcnt(0)" ::: "memory");
    }
}

constexpr int A_KT = 0, A_VT = 9216, A_BUF = 18432, A_IMP = 2 * A_BUF, A_SELM = A_IMP + 64 * 129 * 4, A_UNI = A_SELM + 1024, A_OAS = A_UNI + 16, A_END = A_OAS + 65536;
static_assert(A_END <= 143360 - 16 - 256, "attention LDS");
#define ABAR() do { asm volatile("s_waitcnt lgkmcnt(0)" ::: "memory"); __builtin_amdgcn_s_barrier(); asm volatile("" ::: "memory"); } while (0)
#define MFMA32(a, b, c) __builtin_amdgcn_mfma_f32_32x32x16_bf16((a), (b), (c), 0, 0, 0)
DI float xhalf_max(float v) { auto rr = __builtin_amdgcn_permlane32_swap(__float_as_uint(v), __float_as_uint(v), false, false); return fmaxf(__uint_as_float(rr[0]), __uint_as_float(rr[1])); }
DI float xhalf_other(float v, int hi) { auto rr = __builtin_amdgcn_permlane32_swap(__float_as_uint(v), __float_as_uint(v), false, false); return __uint_as_float(hi ? rr[0] : rr[1]); }
DI float xhalf_sum(float v) { auto rr = __builtin_amdgcn_permlane32_swap(__float_as_uint(v), __float_as_uint(v), false, false); return __uint_as_float(rr[0]) + __uint_as_float(rr[1]); }

struct KVRegs { u32x4 k, v; };
DI void kv_load(KVRegs& r, const bf16_t* Kg, const bf16_t* Vg, int tid) {
    r.k = *(const u32x4*)(Kg + tid * 8);
    if (Vg) r.v = *(const u32x4*)(Vg + (tid & 63) * 64 + (tid >> 6) * 8);
}
DI void kv_store(const KVRegs& r, LAS unsigned char* lds, int tid, bool hasv) {
    const int row = tid >> 3, ch = tid & 7;
    *(LAS u32x4*)(lds + A_KT + row * 144 + ch * 16) = r.k;
    if (hasv) {
        LAS bf16_t* vt = (LAS bf16_t*)(lds + A_VT); const int key = tid & 63, dch = tid >> 6;
#pragma unroll
        for (int e = 0; e < 4; ++e) { const unsigned w = r.v[e]; vt[(dch * 8 + 2 * e) * 68 + key] = (bf16_t)(w & 0xffffu); vt[(dch * 8 + 2 * e + 1) * 68 + key] = (bf16_t)(w >> 16); }
    }
}
DI void tile_scores(f32x16& s0, f32x16& s1, const LAS unsigned char* lds, const bf16x8 (&qr)[4], float bb, float cstep, int r32, int hi) {
    asm volatile("" : "+v"(hi), "+v"(r32));
    const float bb2 = bb + cstep * (float)(4 * hi);
#pragma unroll
    for (int i = 0; i < 16; ++i) { s0[i] = fmaf(cstep, (float)((i & 3) + 8 * (i >> 2)), bb2); s1[i] = fmaf(cstep, (float)((i & 3) + 8 * (i >> 2) + 32), bb2); }
    const LAS unsigned char* kp = lds + A_KT + r32 * 144 + hi * 16;
#pragma unroll
    for (int s = 0; s < 4; ++s) {
        const bf16x8 a0 = *(const LAS bf16x8*)(kp + s * 32), a1 = *(const LAS bf16x8*)(kp + 32 * 144 + s * 32);
        s0 = MFMA32(a0, qr[s], s0); s1 = MFMA32(a1, qr[s], s1);
    }
}
DI void mask_range(f32x16& s0, f32x16& s1, int klo, int khi, int hi) {
    asm volatile("" : "+v"(hi));
#pragma unroll
    for (int i = 0; i < 16; ++i) { const int k = crow(i, hi); s0[i] = (k >= klo && k <= khi) ? s0[i] : -INFINITY; s1[i] = (k + 32 >= klo && k + 32 <= khi) ? s1[i] : -INFINITY; }
}
DI void mask_le(f32x16& s0, f32x16& s1, int khi, int hi) {
    asm volatile("" : "+v"(hi));
    const int kh = khi - 4 * hi;
#pragma unroll
    for (int i = 0; i < 16; ++i) { const int k = (i & 3) + 8 * (i >> 2); s0[i] = (k <= kh) ? s0[i] : -INFINITY; s1[i] = (k + 32 <= kh) ? s1[i] : -INFINITY; }
}
DI void mask_ge(f32x16& s0, f32x16& s1, int klo, int hi) {
    asm volatile("" : "+v"(hi));
    const int kl = klo - 4 * hi;
#pragma unroll
    for (int i = 0; i < 16; ++i) { const int k = (i & 3) + 8 * (i >> 2); s0[i] = (k >= kl) ? s0[i] : -INFINITY; s1[i] = (k + 32 >= kl) ? s1[i] : -INFINITY; }
}
DI void mask_lane(f32x16& s0, f32x16& s1, bool keep) {
#pragma unroll
    for (int i = 0; i < 16; ++i) { s0[i] = keep ? s0[i] : -INFINITY; s1[i] = keep ? s1[i] : -INFINITY; }
}
DI float tile_max(const f32x16& s0, const f32x16& s1) {
    float a = fmaxf(s0[0], s1[0]);
#pragma unroll
    for (int i = 1; i < 16; ++i) a = fmaxf(a, fmaxf(s0[i], s1[i]));
    return xhalf_max(a);
}
DI void pv_tile(f32x16& o0, f32x16& o1, const f32x16& p0, const f32x16& p1, const LAS unsigned char* lds, int r32, int hi) {
    asm volatile("" : "+v"(hi), "+v"(r32));
    const LAS unsigned char* vp = lds + A_VT;
#pragma unroll
    for (int ks = 0; ks < 4; ++ks) {
        u32x4 pw;
        if (ks == 0) { pw.x = cvtpk(p0[0], p0[1]); pw.y = cvtpk(p0[2], p0[3]); pw.z = cvtpk(p0[4], p0[5]); pw.w = cvtpk(p0[6], p0[7]); }
        else if (ks == 1) { pw.x = cvtpk(p0[8], p0[9]); pw.y = cvtpk(p0[10], p0[11]); pw.z = cvtpk(p0[12], p0[13]); pw.w = cvtpk(p0[14], p0[15]); }
        else if (ks == 2) { pw.x = cvtpk(p1[0], p1[1]); pw.y = cvtpk(p1[2], p1[3]); pw.z = cvtpk(p1[4], p1[5]); pw.w = cvtpk(p1[6], p1[7]); }
        else { pw.x = cvtpk(p1[8], p1[9]); pw.y = cvtpk(p1[10], p1[11]); pw.z = cvtpk(p1[12], p1[13]); pw.w = cvtpk(p1[14], p1[15]); }
        const bf16x8 pb = __builtin_bit_cast(bf16x8, pw);
        if (ks == 2) asm volatile("" ::: "memory");
        const int kb = 16 * ks + 4 * hi;
#pragma unroll
        for (int dt = 0; dt < 2; ++dt) {
            const LAS unsigned char* a = vp + ((32 * dt + r32) * 68 + kb) * 2;
            const u32x2 lo = *(const LAS u32x2*)a, hi8 = *(const LAS u32x2*)(a + 16);
            const u32x4 av = {lo.x, lo.y, hi8.x, hi8.y};
            if (dt == 0) o0 = MFMA32(__builtin_bit_cast(bf16x8, av), pb, o0); else o1 = MFMA32(__builtin_bit_cast(bf16x8, av), pb, o1);
        }
    }
}
DI void online_step(float& m, float& l, f32x16& o0, f32x16& o1, f32x16& s0, f32x16& s1) {
    const float mx = tile_max(s0, s1);
    const float mn = fmaxf(m, mx);
    const float mu = (mn == -INFINITY) ? 0.f : mn;
    const float alpha = __builtin_amdgcn_exp2f(m - mu);
    float ls = 0.f;
#pragma unroll
    for (int i = 0; i < 16; ++i) { s0[i] = __builtin_amdgcn_exp2f(s0[i] - mu); s1[i] = __builtin_amdgcn_exp2f(s1[i] - mu); ls += s0[i] + s1[i]; }
    l = l * alpha + ls;
#pragma unroll
    for (int i = 0; i < 16; ++i) { o0[i] *= alpha; o1[i] *= alpha; }
    m = mn;
}

typedef float f32x8 __attribute__((ext_vector_type(8)));
DI void fixed_step(float& l, f32x16& s0, f32x16& s1) {
#pragma unroll
    for (int i = 0; i < 16; ++i) { s0[i] = __builtin_amdgcn_exp2f(s0[i]); s1[i] = __builtin_amdgcn_exp2f(s1[i]); }
    const f32x16 v = s0 + s1;
    const f32x8 a8 = __builtin_shufflevector(v, v, 0, 1, 2, 3, 4, 5, 6, 7) + __builtin_shufflevector(v, v, 8, 9, 10, 11, 12, 13, 14, 15);
    const f32x4 a4 = __builtin_shufflevector(a8, a8, 0, 1, 2, 3) + __builtin_shufflevector(a8, a8, 4, 5, 6, 7);
    const f32x2 a2 = __builtin_shufflevector(a4, a4, 0, 1) + __builtin_shufflevector(a4, a4, 2, 3);
    l += a2[0] + a2[1];
}
DI void stats_step(float& m, float& l, const f32x16& s0, const f32x16& s1) {
    const float mx = tile_max(s0, s1);
    const float mn = fmaxf(m, mx);
    const float mu = (mn == -INFINITY) ? 0.f : mn;
    float ls = 0.f;
#pragma unroll
    for (int i = 0; i < 16; ++i) ls += __builtin_amdgcn_exp2f(s0[i] - mu) + __builtin_amdgcn_exp2f(s1[i] - mu);
    l = l * __builtin_amdgcn_exp2f(m - mu) + ls;
    m = mn;
}
DI void attn_phase(const P& p, LAS unsigned char* lds, int jl) {
    const int tid = TID(), lane = tid & 63, wid = __builtin_amdgcn_readfirstlane(tid >> 6), r32 = lane & 31, hi = lane >> 5;
    const int hh = wid & 3, qh = wid >> 2;
    float wmx[3];
    { const float* qn_ = INP(p, 13) + jl * 256;
#pragma unroll
      for (int ix = 0; ix < 3; ++ix) { float v = fabsf(qn_[(ix + 1) * 64 + lane]);
#pragma unroll
          for (int o = 1; o < 64; o <<= 1) v = fmaxf(v, __shfl_xor(v, o));
          wmx[ix] = __int_as_float(__builtin_amdgcn_readfirstlane(__float_as_int(v))); } }
    const bf16_t* Q = (const bf16_t*)(WSP(p, R_Q));
    const bf16_t* KS = (const bf16_t*)(WSP(p, R_KS)); const bf16_t* VS = (const bf16_t*)(WSP(p, R_VS));
    const bf16_t* KW = (const bf16_t*)(WSP(p, R_KW)); const bf16_t* VW = (const bf16_t*)(WSP(p, R_VW));
    const bf16_t* KC = (const bf16_t*)(WSP(p, R_KCMP)); const bf16_t* VC = (const bf16_t*)(WSP(p, R_VCMP));
    const float* GATES = (const float*)(WSP(p, R_GATES));
    bf16_t* O = (bf16_t*)(WSP(p, R_O));
    LAS float* IMP = (LAS float*)(lds + A_IMP);
    LAS unsigned* SELM = (LAS unsigned*)(lds + A_SELM);
    LAS unsigned* UNI = (LAS unsigned*)(lds + A_UNI);
    LAS float* OAS = (LAS float*)(lds + A_OAS) + tid;

    for (int u = blockIdx.x; u < 1024; u += gridDim.x) {
        const int bg = u & 7, rr_ = u >> 3, kq = rr_ >> 5, wq = rr_ & 31, qb = 32 * kq + ((kq & 1) ? 31 - wq : wq);
        const int b = bg >> 2, g = bg & 3, head = g * 4 + hh, qloc = qh * 32 + r32, t = qb * 64 + qloc, tref = qb * 64;
        const float slope2 = exp2f(-0.5f * (float)(head + 1)) * LOG2E;
        bf16x8 qr[4];
        { const bf16_t* qp = Q + ((size_t)(b * SEQ + t)) * DM + head * 64 + hi * 8;
#pragma unroll
          for (int s = 0; s < 4; ++s) qr[s] = *(const bf16x8*)(qp + s * 16); }
        float qn2 = 0.f;
#pragma unroll
        for (int s_ = 0; s_ < 4; ++s_)
#pragma unroll
            for (int e = 0; e < 8; ++e) { const float x = __uint_as_float(((unsigned)(unsigned short)qr[s_][e]) << 16); qn2 += x * x; }
        const float qnb = sqrtf(xhalf_sum(qn2)) * (8.f * 1.02f);
        for (int i = tid; i < 64 * 129; i += 512) IMP[i] = 0.f;
        if (tid < 256) SELM[tid] = 0u;
        if (tid < 4) UNI[tid] = 0u;
        const size_t bgoff = (size_t)(b * 4 + g);
        KVRegs kr;
        const int ncmp = 4 * qb + 3;
        const int ncb = (ncmp + 63) >> 6;
        const int nmaxq = (t - 31) >> 4;
        const bf16_t* KCb = KC + bgoff * 512 * 64; const bf16_t* VCb = VC + bgoff * 512 * 64;
        float lc = 0.f;
        {
            __syncthreads();
            kv_load(kr, KCb, nullptr, tid); kv_store(kr, lds, tid, false);
            if (ncb > 1) kv_load(kr, KCb + 4096, nullptr, tid);
            ABAR();
            for (int cb = 0; cb < ncb; ++cb) {
                LAS unsigned char* lb = lds + (cb & 1) * A_BUF;
                if (cb + 1 < ncb) { kv_store(kr, lds + ((cb + 1) & 1) * A_BUF, tid, false); if (cb + 2 < ncb) kv_load(kr, KCb + (size_t)(cb + 2) * 4096, nullptr, tid); }
                f32x16 s0, s1;
                tile_scores(s0, s1, lb, qr, slope2 * (float)(1024 * cb + 31 - tref) - (slope2 * (float)qloc + qnb * wmx[0]), slope2 * 16.f, r32, hi);
                mask_le(s0, s1, nmaxq - 64 * cb, hi);
                fixed_step(lc, s0, s1);
                ABAR();
            }
            lc = xhalf_sum(lc);
        }
        {
            const float rl = lc > 0.f ? 1.f / lc : 0.f; const float gate_c = (GATES + (size_t)(b * SEQ + t) * 48 + head)[0];
            float carry = 0.f;
            f32x16 oa0, oa1;
#pragma unroll
            for (int i = 0; i < 16; ++i) { oa0[i] = 0.f; oa1[i] = 0.f; }
            kv_load(kr, KCb, VCb, tid); kv_store(kr, lds, tid, true);
            if (ncb > 1) kv_load(kr, KCb + 4096, VCb + 4096, tid);
            ABAR();
            for (int cb = 0; cb < ncb; ++cb) {
                LAS unsigned char* lb = lds + (cb & 1) * A_BUF;
                if (cb + 1 < ncb) { kv_store(kr, lds + ((cb + 1) & 1) * A_BUF, tid, true); if (cb + 2 < ncb) kv_load(kr, KCb + (size_t)(cb + 2) * 4096, VCb + (size_t)(cb + 2) * 4096, tid); }
                f32x16 s0, s1;
                tile_scores(s0, s1, lb, qr, slope2 * (float)(1024 * cb + 31 - tref) - (slope2 * (float)qloc + qnb * wmx[0]), slope2 * 16.f, r32, hi);
                mask_le(s0, s1, nmaxq - 64 * cb, hi);
#pragma unroll
                for (int i = 0; i < 16; ++i) { s0[i] = __builtin_amdgcn_exp2f(s0[i]) * rl; s1[i] = __builtin_amdgcn_exp2f(s1[i]) * rl; }
                float g4[8], pl[8];
#pragma unroll
                for (int ib = 0; ib < 4; ++ib) { g4[ib] = (s0[4 * ib] + s0[4 * ib + 1]) + (s0[4 * ib + 2] + s0[4 * ib + 3]); pl[ib] = s0[4 * ib + 3];
                                                 g4[4 + ib] = (s1[4 * ib] + s1[4 * ib + 1]) + (s1[4 * ib + 2] + s1[4 * ib + 3]); pl[4 + ib] = s1[4 * ib + 3]; }
                float ppl[8], add[8];
#pragma unroll
                for (int q8 = 0; q8 < 8; ++q8) ppl[q8] = xhalf_other(pl[q8], hi);
#pragma unroll
                for (int q8 = 0; q8 < 8; ++q8) add[q8] = hi ? ppl[q8] : (q8 > 0 ? ppl[q8 - 1] : carry);
                carry = ppl[7];
#pragma unroll
                for (int i = 0; i < 16; ++i) { s0[i] *= gate_c; s1[i] *= gate_c; }
                pv_tile(oa0, oa1, s0, s1, lb, r32, hi);
                for (int turn = 0; turn < 4; ++turn) {
                    if (hh == turn) {
#pragma unroll
                        for (int q8 = 0; q8 < 8; ++q8) { const int j0 = 16 * cb + 2 * q8 + hi; if (j0 < 128) IMP[qloc * 129 + j0] += g4[q8] + add[q8]; }
                    }
                    ABAR();
                }
            }
#pragma unroll
            for (int i = 0; i < 16; ++i) { OAS[i * 512] = oa0[i]; OAS[(16 + i) * 512] = oa1[i]; }
        }
        __syncthreads();
        {
            const int q = tid >> 3, part = tid & 7;
            int val[16]; unsigned mysel = 0u;
#pragma unroll
            for (int e = 0; e < 16; ++e) { const int j = part * 16 + e; val[e] = (j >= 1 && j <= qb - 2) ? __float_as_int(IMP[q * 129 + j]) : -1; }
            const int nf = qb == 0 ? 1 : (qb == 1 ? 2 : 3);
            for (int round = 0; round < 16 - nf; ++round) {
                int lm = val[0];
#pragma unroll
                for (int e = 1; e < 16; ++e) lm = max(lm, val[e]);
                lm = max(lm, dpp_i<0xB1>(lm)); lm = max(lm, dpp_i<0x4E>(lm)); lm = max(lm, dpp_i<0x141>(lm));
                int jm = 255;
#pragma unroll
                for (int e = 0; e < 16; ++e) jm = (val[e] == lm) ? min(jm, part * 16 + e) : jm;
                jm = min(jm, dpp_i<0xB1>(jm)); jm = min(jm, dpp_i<0x4E>(jm)); jm = min(jm, dpp_i<0x141>(jm));
                if (lm >= 0) {
#pragma unroll
                    for (int e = 0; e < 16; ++e) if (part * 16 + e == jm) { val[e] = -1; mysel |= 1u << e; }
                }
            }
#pragma unroll
            for (int e = 0; e < 16; ++e) { const int j = part * 16 + e; if (j == 0 || j == qb || j == qb - 1) mysel |= 1u << e; }
            if (mysel) { const unsigned w = mysel << ((part & 1) * 16); atomicOr((unsigned*)&SELM[q * 4 + (part >> 1)], w); atomicOr((unsigned*)&UNI[part >> 1], w); }
        }
        __syncthreads();
        {
            const unsigned sw0 = SELM[qloc * 4 + 0], sw1 = SELM[qloc * 4 + 1], sw2 = SELM[qloc * 4 + 2], sw3 = SELM[qloc * 4 + 3];
            const unsigned un0 = UNI[0], un1 = UNI[1], un2 = UNI[2], un3 = UNI[3];
            float ls = 0.f; f32x16 o0, o1;
#pragma unroll
            for (int i = 0; i < 16; ++i) { o0[i] = 0.f; o1[i] = 0.f; }
            const bf16_t* Kb = KS + bgoff * 524288; const bf16_t* Vb = VS + bgoff * 524288;
            auto ubit = [&](int j) -> bool { const unsigned w = (j >> 5) == 0 ? un0 : ((j >> 5) == 1 ? un1 : ((j >> 5) == 2 ? un2 : un3)); return (w >> (j & 31)) & 1u; };
            int j = 0, it = 0;
            int jn = 1; while (jn <= qb && !ubit(jn)) ++jn;
            kv_load(kr, Kb, Vb, tid); kv_store(kr, lds, tid, true);
            if (jn <= qb) kv_load(kr, Kb + (size_t)jn * 4096, Vb + (size_t)jn * 4096, tid);
            ABAR();
            while (j <= qb) {
                LAS unsigned char* lb = lds + (it & 1) * A_BUF;
                int jnn = jn + 1; while (jnn <= qb && !ubit(jnn)) ++jnn;
                if (jn <= qb) { kv_store(kr, lds + ((it + 1) & 1) * A_BUF, tid, true); if (jnn <= qb) kv_load(kr, Kb + (size_t)jnn * 4096, Vb + (size_t)jnn * 4096, tid); }
                const unsigned w = (j >> 5) == 0 ? sw0 : ((j >> 5) == 1 ? sw1 : ((j >> 5) == 2 ? sw2 : sw3));
                const bool sel = (w >> (j & 31)) & 1u;
                if (__any(sel)) {
                    f32x16 s0, s1;
                    tile_scores(s0, s1, lb, qr, sel ? slope2 * (float)(64 * j - tref) - (slope2 * (float)qloc + qnb * wmx[1]) : -INFINITY, slope2, r32, hi);
                    if (j == qb) mask_le(s0, s1, qloc, hi);
                    fixed_step(ls, s0, s1);
                    pv_tile(o0, o1, s0, s1, lb, r32, hi);
                }
                ABAR();
                j = jn; jn = jnn; ++it;
            }
            ls = xhalf_sum(ls);
            const float f = (GATES + (size_t)(b * SEQ + t) * 48 + head)[16] * (ls > 0.f ? 1.f / ls : 0.f);
#pragma unroll
            for (int i = 0; i < 16; ++i) { OAS[i * 512] += f * o0[i]; OAS[(16 + i) * 512] += f * o1[i]; }
        }
        {
            float lw = 0.f; f32x16 o0, o1;
#pragma unroll
            for (int i = 0; i < 16; ++i) { o0[i] = 0.f; o1[i] = 0.f; }
            const bf16_t* Kb = KW + bgoff * 524288; const bf16_t* Vb = VW + bgoff * 524288;
            const int j0 = qb >= 8 ? qb - 8 : 0;
            kv_load(kr, Kb + (size_t)j0 * 4096, Vb + (size_t)j0 * 4096, tid); kv_store(kr, lds, tid, true);
            if (j0 + 1 <= qb) kv_load(kr, Kb + (size_t)(j0 + 1) * 4096, Vb + (size_t)(j0 + 1) * 4096, tid);
            ABAR();
            for (int j = j0; j <= qb; ++j) {
                LAS unsigned char* lb = lds + ((j - j0) & 1) * A_BUF;
                if (j + 1 <= qb) { kv_store(kr, lds + ((j - j0 + 1) & 1) * A_BUF, tid, true); if (j + 2 <= qb) kv_load(kr, Kb + (size_t)(j + 2) * 4096, Vb + (size_t)(j + 2) * 4096, tid); }
                f32x16 s0, s1;
                tile_scores(s0, s1, lb, qr, slope2 * (float)(64 * j - tref) - (slope2 * (float)qloc + qnb * wmx[2]), slope2, r32, hi);
                if (j == qb) mask_le(s0, s1, qloc, hi);
                else if (j == qb - 8) mask_ge(s0, s1, qloc + 1, hi);
                fixed_step(lw, s0, s1);
                pv_tile(o0, o1, s0, s1, lb, r32, hi);
                ABAR();
            }
            lw = xhalf_sum(lw);
            const float f = (GATES + (size_t)(b * SEQ + t) * 48 + head)[32] * (lw > 0.f ? 1.f / lw : 0.f);
            f32x16 oa0, oa1;
#pragma unroll
            for (int i = 0; i < 16; ++i) { oa0[i] = OAS[i * 512] + f * o0[i]; oa1[i] = OAS[(16 + i) * 512] + f * o1[i]; }
          bf16_t* op = O + (size_t)(b * SEQ + t) * DM + head * 64 + 4 * hi;
#pragma unroll
          for (int ib = 0; ib < 4; ++ib) {
              st_bf4(op + 8 * ib, (f32x4){oa0[4 * ib], oa0[4 * ib + 1], oa0[4 * ib + 2], oa0[4 * ib + 3]});
              st_bf4(op + 32 + 8 * ib, (f32x4){oa1[4 * ib], oa1[4 * ib + 1], oa1[4 * ib + 2], oa1[4 * ib + 3]}); } }
        __syncthreads();
    }
}

template <int CTRL> DI float dpp_f(float v) { return __int_as_float(__builtin_amdgcn_update_dpp(0, __float_as_int(v), CTRL, 0xf, 0xf, false)); }
DI float allreduce16(float v) { v += dpp_f<0xB1>(v); v += dpp_f<0x4E>(v); v += dpp_f<0x141>(v); v += dpp_f<0x140>(v); return v; }
DI void unpack8(const u32x4& w, float* f) {
#pragma unroll
    for (int e = 0; e < 4; ++e) { f[2 * e] = __uint_as_float(w[e] << 16); f[2 * e + 1] = __uint_as_float(w[e] & 0xffff0000u); }
}
DI float quad_sum(float v) { v += dpp_f<0xB1>(v); v += dpp_f<0x4E>(v); return v; }
DI void rwkv_prep_phase(const P& p) {
    const int tid_ = TID(), lane = tid_ & 63, gw = blockIdx.x * 8 + (tid_ >> 6), NGW = gridDim.x * 8;
    const bf16_t* RKV = (const bf16_t*)(WSP(p, R_RKV)); const bf16_t* WAG = (const bf16_t*)(WSP(p, R_WAG));
    f32x4* SC = (f32x4*)(WSP(p, R_LORAH));
    const float* kkp = INP(p, 25) + 16 * lane; const float* kap = INP(p, 26) + 16 * lane; const float* rkp = INP(p, 27) + 16 * lane;
    for (int m = gw; m < MTOK; m += NGW) {
        const int t = m & 8191; const size_t idx = (size_t)m * DM + 16 * lane; const size_t idn = (size_t)(t < SEQ - 1 ? m + 1 : m) * DM + 16 * lane;
        float r[16], k[16], kn[16], a[16];
        { const u32x4* q; q = (const u32x4*)(RKV + idx); const u32x4 r0 = q[0], r1 = q[1]; q = (const u32x4*)(RKV + (size_t)MTOK * DM + idx); const u32x4 k0 = q[0], k1 = q[1];
          q = (const u32x4*)(RKV + (size_t)MTOK * DM + idn); const u32x4 n0 = q[0], n1 = q[1]; q = (const u32x4*)(WAG + (size_t)MTOK * DM + idx); const u32x4 a0 = q[0], a1 = q[1];
          unpack8(r0, r); unpack8(r1, r + 8); unpack8(k0, k); unpack8(k1, k + 8); unpack8(n0, kn); unpack8(n1, kn + 8); unpack8(a0, a); unpack8(a1, a + 8); }
        float s0 = 0.f, s1 = 0.f;
#pragma unroll
        for (int e = 0; e < 16; ++e) { const float x0 = k[e] * kkp[e], x1 = kn[e] * kkp[e]; s0 += x0 * x0; s1 += x1 * x1; }
        const float rs0 = rsqrtf(fmaxf(quad_sum(s0), 1e-24f)), rs1 = rsqrtf(fmaxf(quad_sum(s1), 1e-24f));
        float c1 = 0.f, c2 = 0.f, bn = 0.f;
#pragma unroll
        for (int e = 0; e < 16; ++e) { const float kk = k[e] * kkp[e] * rs0, kx = kn[e] * kkp[e] * rs1, kp = k[e] * (1.f + (a[e] - 1.f) * kap[e]);
            c1 += kk * a[e] * kx; c2 += kp * kx; bn += r[e] * kp * rkp[e]; }
        c1 = quad_sum(c1); c2 = quad_sum(c2); bn = quad_sum(bn);
        if ((lane & 3) == 0) SC[(size_t)m * 16 + (lane >> 2)] = (f32x4){rs0, c1, c2, bn};
    }
}
DI float wave_sum_fast(float v) {
    v = allreduce16(v);
    const int vi = __float_as_int(v);
    const float r0 = __int_as_float(__builtin_amdgcn_readlane(vi, 0)), r1 = __int_as_float(__builtin_amdgcn_readlane(vi, 16)), r2 = __int_as_float(__builtin_amdgcn_readlane(vi, 32)), r3 = __int_as_float(__builtin_amdgcn_readlane(vi, 48));
    return (r0 + r1) + (r2 + r3);
}
#define SCAN_BAR() do { asm volatile("s_waitcnt lgkmcnt(0)" ::: "memory"); __builtin_amdgcn_s_barrier(); asm volatile("" ::: "memory"); } while (0)
DI float allreduce8(float v) { v += dpp_f<0xB1>(v); v += dpp_f<0x4E>(v); v += dpp_f<0x141>(v); return v; }
constexpr int SC_CH = 16;
constexpr int SC_BUF_F = 5 * SC_CH * 64 + SC_CH * 64 + 2 * SC_CH;
constexpr int SC_Y_F = SC_CH * 8 * 8;
constexpr int SC_OFF_Y = 4 * SC_BUF_F, SC_OFF_KK0 = SC_OFF_Y + 6 * SC_Y_F, SC_OFF_TAB = SC_OFF_KK0 + 64;
static_assert((SC_OFF_TAB + 16) * 4 <= 143360 - 16 - 256, "scan LDS");
DI void scan_phase(const P& p, LAS unsigned char* lds) {
    const int tid = TID(), lane = tid & 63, wv = __builtin_amdgcn_readfirstlane(tid >> 6);
    const int chain = blockIdx.x >> 3, r8 = blockIdx.x & 7, b = chain >> 4, h = chain & 15;
    LAS float* fl = (LAS float*)lds;
    int role = 0, ridx = 0;
    {
        LAS int* simdtab = (LAS int*)(fl + SC_OFF_TAB);
        if (lane == 0) simdtab[wv] = (int)(__builtin_amdgcn_s_getreg((1 << 11) | (4 << 6) | 4) & 3u);
        __syncthreads();
        int sid[8], rl[8];
#pragma unroll
        for (int i = 0; i < 8; ++i) { sid[i] = __builtin_amdgcn_readfirstlane(simdtab[i]); rl[i] = 2; }
        unsigned used = 0u; int ncmp = 0;
#pragma unroll
        for (int i = 0; i < 8; ++i) if (ncmp < 3 && !((used >> sid[i]) & 1u)) { rl[i] = 0; used |= 1u << sid[i]; ++ncmp; }
#pragma unroll
        for (int i = 0; i < 8; ++i) if (ncmp < 3 && rl[i] == 2) { rl[i] = 0; ++ncmp; }
        int nwr = 0;
#pragma unroll
        for (int i = 7; i >= 0; --i) if (nwr < 1 && rl[i] == 2 && ((used >> sid[i]) & 1u)) { rl[i] = 1; ++nwr; }
#pragma unroll
        for (int i = 7; i >= 0; --i) if (nwr < 1 && rl[i] == 2) { rl[i] = 1; ++nwr; }
        int cnt0 = 0, cnt1 = 0, cnt2 = 0;
#pragma unroll
        for (int i = 0; i < 8; ++i) { if (i == wv) { role = rl[i]; ridx = rl[i] == 0 ? cnt0 : (rl[i] == 1 ? cnt1 : cnt2); } cnt0 += rl[i] == 0; cnt1 += rl[i] == 1; cnt2 += rl[i] == 2; }
    }
    if (role == 2) {
        const int sg = ridx >> 1, sw = ridx & 1;
        const bf16_t* RKV = (const bf16_t*)(WSP(p, R_RKV)); const bf16_t* WAG = (const bf16_t*)(WSP(p, R_WAG));
        const bf16_t* Rg = RKV; const bf16_t* Kg = RKV + (size_t)MTOK * DM; const bf16_t* Vg = RKV + (size_t)2 * MTOK * DM;
        const bf16_t* Eg = WAG; const bf16_t* Ag = WAG + (size_t)MTOK * DM;
        const float kkc = INP(p, 25)[h * 64 + lane], kac = INP(p, 26)[h * 64 + lane];
        const f32x4* SC = (const f32x4*)(WSP(p, R_LORAH)) + h;
        bf16_t rr[8], kr[9], vr[8], er[8], ar[8]; f32x4 sc[9];
        auto load_chunk = [&](int c) {
            const int t0 = sg * 4096 + c * SC_CH + sw * 8;
#pragma unroll
            for (int s8 = 0; s8 < 8; ++s8) { const size_t tok = (size_t)(b * SEQ + t0 + s8); const size_t idx = tok * DM + h * 64 + lane;
                rr[s8] = Rg[idx]; kr[s8] = Kg[idx]; vr[s8] = Vg[idx]; er[s8] = Eg[idx]; ar[s8] = Ag[idx]; sc[s8] = SC[tok * 16]; }
            { const size_t tok = (size_t)(b * SEQ + min(t0 + 8, SEQ - 1)); kr[8] = Kg[tok * DM + h * 64 + lane]; sc[8] = SC[tok * 16]; }
        };
        auto store_chunk = [&](int bufi, bool first) {
            LAS float* bp = fl + (sg * 2 + bufi) * SC_BUF_F;
#pragma unroll
            for (int s8 = 0; s8 < 8; ++s8) { const int st = sw * 8 + s8;
                const float kf = bf2f(kr[s8]), af = bf2f(ar[s8]);
                const float w = __expf(-bf2f(er[s8])); const float kp = kf * (1.f + (af - 1.f) * kac); const float kk = kf * kkc * sc[s8][0]; const float kn = bf2f(kr[s8 + 1]) * kkc * sc[s8 + 1][0];
                if (first && sw == 0 && s8 == 0) fl[SC_OFF_KK0 + lane] = kk;
                bp[0 * SC_CH * 64 + st * 64 + lane] = w * kn; bp[1 * SC_CH * 64 + st * 64 + lane] = w; bp[2 * SC_CH * 64 + st * 64 + lane] = kk * af;
                bp[3 * SC_CH * 64 + st * 64 + lane] = kp; bp[4 * SC_CH * 64 + st * 64 + lane] = bf2f(rr[s8]); bp[5 * SC_CH * 64 + st * 64 + lane] = bf2f(vr[s8]);
                if (lane == 0) { bp[6 * SC_CH * 64 + st * 2] = sc[s8][1]; bp[6 * SC_CH * 64 + st * 2 + 1] = sc[s8][2]; } }
        };
        load_chunk(0); store_chunk(0, sg == 1); load_chunk(1);
        SCAN_BAR();
        for (int c = 0; c < 256; ++c) {
            if (c + 1 < 256) store_chunk((c + 1) & 1, false);
            if (c + 2 < 256) load_chunk(c + 2);
            SCAN_BAR();
        }
    } else if (role == 1) {
        const int idx = lane * 2, st = idx >> 3, rl = idx & 7;
        bf16_t* Y = (bf16_t*)(WSP(p, R_Y)); float* YM = (float*)(WSP(p, WS_HB));
        bf16_t* yA = Y + ((size_t)(b * SEQ + st)) * DM + h * 64 + r8 * 8 + rl; bf16_t* yC = yA + (size_t)4096 * DM;
        float* yM = YM + ((size_t)(b * 4096 + st)) * DM + h * 64 + r8 * 8 + rl;
        auto ysum = [&](const LAS float* yb, float& o0, float& o1) {
            const LAS f32x4* q = (const LAS f32x4*)(yb + idx * 8);
            const f32x4 a0 = q[0], a1 = q[1], b0 = q[2], b1 = q[3];
            const f32x4 sa_ = a0 + a1, sb_ = b0 + b1;
            o0 = (sa_[0] + sa_[1]) + (sa_[2] + sa_[3]); o1 = (sb_[0] + sb_[1]) + (sb_[2] + sb_[3]);
        };
        auto flush = [&](int c) {
            const LAS float* yb = fl + SC_OFF_Y + (c & 1) * SC_Y_F; float o0, o1; const size_t off = (size_t)c * SC_CH * DM;
            ysum(yb, o0, o1); *(unsigned*)(yA + off) = cvtpk(o0, o1);
            ysum(yb + 2 * SC_Y_F, o0, o1); *(unsigned*)(yC + off) = cvtpk(o0, o1);
            ysum(yb + 4 * SC_Y_F, o0, o1); *(f32x2*)(yM + off) = (f32x2){o0, o1};
        };
        SCAN_BAR();
        for (int c = 0; c < 256; ++c) {
            if (c > 0) flush(c - 1);
            SCAN_BAR();
        }
        flush(255);
    } else {
        const int set = ridx, sg = set == 0 ? 0 : 1, ri = lane >> 3, cq = lane & 7, row = r8 * 8 + ri;
        f32x2 s0 = {0.f, 0.f}, s1 = s0, s2 = s0, s3 = s0;
        if (set == 2) { const int d = row - 8 * cq; s0[0] = d == 0 ? 1.f : 0.f; s0[1] = d == 1 ? 1.f : 0.f; s1[0] = d == 2 ? 1.f : 0.f; s1[1] = d == 3 ? 1.f : 0.f;
                        s2[0] = d == 4 ? 1.f : 0.f; s2[1] = d == 5 ? 1.f : 0.f; s3[0] = d == 6 ? 1.f : 0.f; s3[1] = d == 7 ? 1.f : 0.f; }
        const float vmul = set == 2 ? 0.f : 1.f;
        __builtin_amdgcn_s_setprio(2);
        SCAN_BAR();
        float sa = set == 2 ? -fl[SC_OFF_KK0 + row] : 0.f;
        for (int c = 0; c < 256; ++c) {
            const LAS float* bp = fl + (sg * 2 + (c & 1)) * SC_BUF_F + 8 * cq; const LAS float* vp = fl + (sg * 2 + (c & 1)) * SC_BUF_F + 5 * SC_CH * 64 + row;
            const LAS float* cp = fl + (sg * 2 + (c & 1)) * SC_BUF_F + 6 * SC_CH * 64;
            LAS float* yb = fl + SC_OFF_Y + (set * 2 + (c & 1)) * SC_Y_F + ri * 8 + cq;
            struct StepV { f32x4 qa, qb, wa, wb, ba, bb, pa, pb, ra, rb; float vv; f32x2 cc; };
            auto ldstep = [&](int st_) -> StepV {
                StepV v_;
                v_.qa = *(const LAS f32x4*)(bp + 0 * SC_CH * 64 + st_ * 64); v_.qb = *(const LAS f32x4*)(bp + 0 * SC_CH * 64 + st_ * 64 + 4);
                v_.wa = *(const LAS f32x4*)(bp + 1 * SC_CH * 64 + st_ * 64); v_.wb = *(const LAS f32x4*)(bp + 1 * SC_CH * 64 + st_ * 64 + 4);
                v_.ba = *(const LAS f32x4*)(bp + 2 * SC_CH * 64 + st_ * 64); v_.bb = *(const LAS f32x4*)(bp + 2 * SC_CH * 64 + st_ * 64 + 4);
                v_.pa = *(const LAS f32x4*)(bp + 3 * SC_CH * 64 + st_ * 64); v_.pb = *(const LAS f32x4*)(bp + 3 * SC_CH * 64 + st_ * 64 + 4);
                v_.ra = *(const LAS f32x4*)(bp + 4 * SC_CH * 64 + st_ * 64); v_.rb = *(const LAS f32x4*)(bp + 4 * SC_CH * 64 + st_ * 64 + 4);
                v_.vv = vp[st_ * 64] * vmul; v_.cc = *(const LAS f32x2*)(cp + st_ * 2);
                return v_;
            };
            StepV c0 = ldstep(0), c1 = ldstep(1);
#pragma unroll
            for (int st = 0; st < SC_CH; ++st) {
                const StepV c2 = ldstep(st + 2 < SC_CH ? st + 2 : SC_CH - 1);
                __builtin_amdgcn_sched_barrier(0x207);
                const f32x4 qa = c0.qa, qb = c0.qb, wa = c0.wa, wb = c0.wb, ba = c0.ba, bb = c0.bb, pa = c0.pa, pb = c0.pb, ra = c0.ra, rb = c0.rb; const float vv = c0.vv; const f32x2 cc = c0.cc;
                f32x2 t = s0 * (f32x2){qa[0], qa[1]}; t = s1 * (f32x2){qa[2], qa[3]} + t;
                f32x2 t2 = s2 * (f32x2){qb[0], qb[1]}; t2 = s3 * (f32x2){qb[2], qb[3]} + t2; t = t + t2;
                const float Rp = t[0] + t[1];
                const f32x2 vk = {vv, vv}; const f32x2 sa2 = {sa, sa};
                s0 = s0 * (f32x2){wa[0], wa[1]} + (sa2 * (f32x2){ba[0], ba[1]} + vk * (f32x2){pa[0], pa[1]});
                s1 = s1 * (f32x2){wa[2], wa[3]} + (sa2 * (f32x2){ba[2], ba[3]} + vk * (f32x2){pa[2], pa[3]});
                s2 = s2 * (f32x2){wb[0], wb[1]} + (sa2 * (f32x2){bb[0], bb[1]} + vk * (f32x2){pb[0], pb[1]});
                s3 = s3 * (f32x2){wb[2], wb[3]} + (sa2 * (f32x2){bb[2], bb[3]} + vk * (f32x2){pb[2], pb[3]});
                f32x2 u = s0 * (f32x2){ra[0], ra[1]}; u = s1 * (f32x2){ra[2], ra[3]} + u;
                f32x2 u2 = s2 * (f32x2){rb[0], rb[1]}; u2 = s3 * (f32x2){rb[2], rb[3]} + u2; u = u + u2;
                yb[st * 64] = u[0] + u[1];
                const float R = allreduce8(Rp);
                sa = -(R + (sa * cc[0] + vv * cc[1]));
                c0 = c1; c1 = c2;
            }
            SCAN_BAR();
        }
        __builtin_amdgcn_s_setprio(0);
        if (set == 0) {
            float* SF = (float*)(WSP(p, R_LORAH + 4 * MiB)) + ((size_t)chain * 64 + row) * 64 + 8 * cq;
            *(f32x4*)SF = (f32x4){s0[0], s0[1], s1[0], s1[1]}; *(f32x4*)(SF + 4) = (f32x4){s2[0], s2[1], s3[0], s3[1]};
        }
    }
}
DI void scan_fixup_phase(const P& p, LAS unsigned char* lds) {
    const int tid = TID(), i = tid & 63, tq = tid >> 6;
    const int chain = blockIdx.x >> 3, slice = blockIdx.x & 7, b = chain >> 4, h = chain & 15;
    LAS float* S = (LAS float*)lds;
    const float* SF = (const float*)(WSP(p, R_LORAH + 4 * MiB)) + (size_t)chain * 4096;
    for (int e = tid; e < 4096; e += 512) S[(e >> 6) * 65 + (e & 63)] = SF[e];
    __syncthreads();
    bf16_t* Y = (bf16_t*)(WSP(p, R_Y)); const float* YM = (const float*)(WSP(p, WS_HB));
    f32x4 cur[16], nxt[16]; bf16_t ycur, ynxt;
    auto issue = [&](int g, f32x4 (&dst)[16], bf16_t& yv) {
        const int tl = slice * 512 + g * 8 + tq;
        const f32x4* ym = (const f32x4*)(YM + ((size_t)(b * 4096 + tl)) * DM + h * 64);
#pragma unroll
        for (int q4 = 0; q4 < 16; ++q4) dst[q4] = ym[q4];
        yv = Y[((size_t)(b * SEQ + 4096 + tl)) * DM + h * 64 + i];
    };
    issue(0, cur, ycur);
    for (int g = 0; g < 64; ++g) {
        if (g + 1 < 64) issue(g + 1, nxt, ynxt);
        float acc = 0.f;
#pragma unroll
        for (int q4 = 0; q4 < 16; ++q4) { const f32x4 m4 = cur[q4]; const LAS float* sr = S + i * 65 + 4 * q4; acc += (sr[0] * m4[0] + sr[1] * m4[1]) + (sr[2] * m4[2] + sr[3] * m4[3]); }
        const int tl = slice * 512 + g * 8 + tq;
        Y[((size_t)(b * SEQ + 4096 + tl)) * DM + h * 64 + i] = f2bf(bf2f(ycur) + acc);
#pragma unroll
        for (int q4 = 0; q4 < 16; ++q4) cur[q4] = nxt[q4];
        ycur = ynxt;
    }
}
DI void rwkv_gn_phase(const P& p) {
    const int tid_ = TID(), lane = tid_ & 63, gw = blockIdx.x * 8 + (tid_ >> 6), NGW = gridDim.x * 8;
    const bf16_t* RKV = (const bf16_t*)(WSP(p, R_RKV)); const bf16_t* WAG = (const bf16_t*)(WSP(p, R_WAG)); const bf16_t* Y = (const bf16_t*)(WSP(p, R_Y));
    const f32x4* SC = (const f32x4*)(WSP(p, R_LORAH));
    bf16_t* HB = (bf16_t*)(WSP(p, WS_HB));
    const float* lnw = INP(p, 28) + 16 * lane; const float* lnb = INP(p, 29) + 16 * lane;
    for (int m = gw; m < MTOK; m += NGW) {
        const int b = m >> 13; const size_t idx = (size_t)m * DM + 16 * lane;
        float y[16], v[16], g[16];
        { const u32x4* q; q = (const u32x4*)(Y + idx); const u32x4 y0 = q[0], y1 = q[1];
          q = (const u32x4*)(RKV + (size_t)2 * MTOK * DM + idx); const u32x4 v0 = q[0], v1 = q[1];
          q = (const u32x4*)(WAG + (size_t)2 * MTOK * DM + idx); const u32x4 g0 = q[0], g1 = q[1];
          unpack8(y0, y); unpack8(y1, y + 8); unpack8(v0, v); unpack8(v1, v + 8); unpack8(g0, g); unpack8(g1, g + 8); }
        const float bn = SC[(size_t)m * 16 + (lane >> 2)][3];
        float s = 0.f;
#pragma unroll
        for (int e = 0; e < 16; ++e) s += y[e];
        const float mean = quad_sum(s) * (1.f / 64.f);
        float q2 = 0.f;
#pragma unroll
        for (int e = 0; e < 16; ++e) { y[e] -= mean; q2 += y[e] * y[e]; }
        const float rstd = rsqrtf(quad_sum(q2) * (1.f / 64.f) + 64e-5f);
        u32x4 o0, o1;
#pragma unroll
        for (int e = 0; e < 4; ++e) {
            const float f0 = (y[2 * e] * rstd * lnw[2 * e] + lnb[2 * e] + bn * v[2 * e]) * g[2 * e], f1 = (y[2 * e + 1] * rstd * lnw[2 * e + 1] + lnb[2 * e + 1] + bn * v[2 * e + 1]) * g[2 * e + 1];
            const float f2 = (y[8 + 2 * e] * rstd * lnw[8 + 2 * e] + lnb[8 + 2 * e] + bn * v[8 + 2 * e]) * g[8 + 2 * e], f3 = (y[9 + 2 * e] * rstd * lnw[9 + 2 * e] + lnb[9 + 2 * e] + bn * v[9 + 2 * e]) * g[9 + 2 * e];
            o0[e] = cvtpk(f0, f1); o1[e] = cvtpk(f2, f3); }
        u32x4* op = (u32x4*)(HB + (size_t)(m + 1 + b) * DM + 16 * lane); op[0] = o0; op[1] = o1;
    }
}
DI void pool_phase(const P& p) {
    const int tid_ = TID(), lane = tid_ & 63, gw = blockIdx.x * 8 + (tid_ >> 6), NGW = gridDim.x * 8;
    const bf16_t* HB = (const bf16_t*)(WSP(p, WS_HB)); bf16_t* PO = (bf16_t*)(WSP(p, R_POOLED));
    const int win = 2 << (lane >> 4);
    for (int m = gw; m < MTOK; m += NGW) {
        const int b = m >> 13, t = m & 8191; const bf16_t* hp = HB + (size_t)(m + 1 + b) * DM + 16 * lane;
        const int nwin = min(win, t + 1);
        u32x4 lo[16], hi8[16];
#pragma unroll
        for (int u = 0; u < 16; ++u) { const int uu = u < nwin ? u : 0; lo[u] = *(const u32x4*)(hp - (size_t)uu * DM); hi8[u] = *(const u32x4*)(hp - (size_t)uu * DM + 8); }
        float acc[16], self[16];
#pragma unroll
        for (int e = 0; e < 16; ++e) acc[e] = 0.f;
#pragma unroll
        for (int u = 0; u < 16; ++u) {
            const float msk = u < nwin ? 1.f : 0.f;
#pragma unroll
            for (int e = 0; e < 4; ++e) { const float f0 = __uint_as_float(lo[u][e] << 16), f1 = __uint_as_float(lo[u][e] & 0xffff0000u), f2 = __uint_as_float(hi8[u][e] << 16), f3 = __uint_as_float(hi8[u][e] & 0xffff0000u);
                acc[2 * e] += msk * f0; acc[2 * e + 1] += msk * f1; acc[8 + 2 * e] += msk * f2; acc[8 + 2 * e + 1] += msk * f3;
                if (u == 0) { self[2 * e] = f0; self[2 * e + 1] = f1; self[8 + 2 * e] = f2; self[8 + 2 * e + 1] = f3; } }
        }
        const float inv = 1.f / (float)nwin;
        u32x4 o0, o1;
#pragma unroll
        for (int e = 0; e < 4; ++e) { o0[e] = cvtpk(acc[2 * e] * inv - self[2 * e], acc[2 * e + 1] * inv - self[2 * e + 1]); o1[e] = cvtpk(acc[8 + 2 * e] * inv - self[8 + 2 * e], acc[8 + 2 * e + 1] * inv - self[8 + 2 * e + 1]); }
        *(u32x4*)(PO + (size_t)m * DM + 16 * lane) = o0; *(u32x4*)(PO + (size_t)m * DM + 16 * lane + 8) = o1;
    }
}


#define XB_TMO      128
#define XB_XCNT(j)  (256  + 64 * (j))
#define XB_XSUB(j)  (1280 + 64 * (j))
#define XB_XGEN(j)  (2304 + 64 * (j))
#define XB_TOP      3328
#define XB_TOPGEN   3392
#define XCD_BAR_WORDS 3456
#define XB_SPIN_CAP (1u << 22)
DI unsigned xb_ld(unsigned* p) { return __hip_atomic_load(p, __ATOMIC_RELAXED, __HIP_MEMORY_SCOPE_AGENT); }
DI unsigned xb_add(unsigned* p, unsigned v) { return __hip_atomic_fetch_add(p, v, __ATOMIC_RELAXED, __HIP_MEMORY_SCOPE_AGENT); }
DI unsigned xb_xcc_id() { return (unsigned)__builtin_amdgcn_s_getreg((3 << 11) | 20) & 0xFu; }
#define XB_SPIN(cond, bar) do { unsigned _sp = 0; while (cond) { __builtin_amdgcn_s_sleep(1); \
    if ((++_sp & 255u) == 0u) { if (xb_ld(&(bar)[XB_TMO])) break; if (_sp > XB_SPIN_CAP) { atomicAdd(&(bar)[XB_TMO], 1u); break; } } } } while (0)
struct XcdBarrier { unsigned* bar; unsigned x; volatile LAS unsigned* st; };
DI XcdBarrier xcd_barrier_post(unsigned* bar, volatile LAS unsigned* st) {
    XcdBarrier b; b.bar = bar; b.x = xb_xcc_id(); b.st = st;
    if (threadIdx.x == 0) (void)xb_add(&bar[XB_XCNT(b.x)], 1u);
    return b;
}
DI void xcd_barrier_complete(unsigned* bar, unsigned x, unsigned& nloc, unsigned& nx) {
    const unsigned G = gridDim.x * gridDim.y * gridDim.z;
    unsigned sum, cnt, mine, sp = 0u;
    for (;;) {
        sum = 0u; cnt = 0u; mine = 0u;
#pragma unroll
        for (unsigned j = 0; j < 16; ++j) { const unsigned c = xb_ld(&bar[XB_XCNT(j)]); sum += c; cnt += (c > 0u) ? 1u : 0u; mine = (j == x) ? c : mine; }
        if (sum == G) break;
        __builtin_amdgcn_s_sleep(1);
        if ((++sp & 255u) == 0u) { if (xb_ld(&bar[XB_TMO])) break; if (sp > XB_SPIN_CAP) { atomicAdd(&bar[XB_TMO], 1u); break; } }
    }
    nloc = mine > 0u ? mine : 1u; nx = cnt > 0u ? cnt : 1u;
}
DI void xcd_barrier(const P& p, LAS unsigned char* lds) {
    XcdBarrier b; b.bar = (unsigned*)WSP(p, WS_BAR); b.x = xb_xcc_id(); b.st = (volatile LAS unsigned*)(lds + LDS_BYTES - 16);
    asm volatile("s_waitcnt vmcnt(0)" ::: "memory");
    __syncthreads();
    if (TID() == 0) {
        unsigned* bar = b.bar;
        __builtin_amdgcn_s_waitcnt(0);
        unsigned nloc = b.st[0], nx = b.st[1];
        if (nloc == 0u) { xcd_barrier_complete(bar, b.x, nloc, nx); b.st[0] = nloc; b.st[1] = nx; }
        const unsigned old = xb_add(&bar[XB_XSUB(b.x)], 1u);
        const unsigned gen = old / nloc;
        if (old + 1u == (gen + 1u) * nloc) {
            __builtin_amdgcn_fence(__ATOMIC_RELEASE, "agent");
            asm volatile("s_waitcnt vmcnt(0)" ::: "memory");
            const unsigned og = xb_add(&bar[XB_TOP], 1u);
            const unsigned tg = og / nx;
            if (og + 1u == (tg + 1u) * nx) xb_add(&bar[XB_TOPGEN], 1u);
            else XB_SPIN(xb_ld(&bar[XB_TOPGEN]) == tg, bar);
            __builtin_amdgcn_fence(__ATOMIC_ACQUIRE, "agent");
            xb_add(&bar[XB_XGEN(b.x)], 1u);
            asm volatile("s_waitcnt vmcnt(0)" ::: "memory");
        } else {
            XB_SPIN(xb_ld(&bar[XB_XGEN(b.x)]) == gen, bar);
            __builtin_amdgcn_fence(__ATOMIC_ACQUIRE, "agent");
            asm volatile("s_waitcnt vmcnt(0)" ::: "memory");
        }
    }
    __syncthreads();
}
__global__ void __launch_bounds__(512, 2) fwd_kernel(P p) {
    LAS unsigned char* lds = (LAS unsigned char*)lds_raw;
    if ((threadIdx.x & 63) == 0) ((volatile LAS int*)(lds + WAVEMAP_OFF))[hw_wave_key()] = (int)(threadIdx.x >> 6);
    cg::grid_group grid = cg::this_grid();
    volatile LAS unsigned* xst = (volatile LAS unsigned*)(lds + LDS_BYTES - 16);
    if (threadIdx.x < 4) xst[threadIdx.x] = 0u;
    __syncthreads();
    (void)xcd_barrier_post((unsigned*)(p.ws + WS_BAR), xst);
#define GSYNC() xcd_barrier(p, lds)
    const int G = gridDim.x, bx = blockIdx.x;
    float* x = p.out;
#define MOD ((const float*)(WSP(p, WS_MOD)))
#define HB ((bf16_t*)(WSP(p, WS_HB)))
#define HA ((const bf16_t*)(WSP(p, WS_HB + 2048)))
    pg8::StaticOrder S;

    if (PH & 1) p0_phase(p, lds);
    if (DUP & 16) { __syncthreads(); p0_phase(p, lds); }
    if (p.ws == nullptr) grid.sync();
    GSYNC();

    for (int layer = 0; layer < 4; ++layer) {
        const int kind = layer % 3, j = layer / 3;
        const float* mod = MOD + (size_t)layer * 2 * 6144;
        if (PH & 2) norm_phase(layer == 0 ? INP(p, 0) : x, nullptr, HB, INP(p, 4) + layer * DM, mod + 0, mod + 1024);
        GSYNC();
        if (kind == 0) {
            { pg8::Gemm g{HA, (const bf16_t*)(WSP(p, W_NSA_IN + j * SZ_NSA_IN)), MTOK, NSA_INP, 1024, 1024, 2048, 0}; S.init(MTOK, NSA_INP, G, bx);
              EpiNsaIn E{(bf16_t*)(WSP(p, R_Q)), (bf16_t*)(WSP(p, R_KCV)), (bf16_t*)(WSP(p, R_KS)), (bf16_t*)(WSP(p, R_VS)), (bf16_t*)(WSP(p, R_KW)), (bf16_t*)(WSP(p, R_VW)), (float*)(WSP(p, R_GATES)), INP(p, 13) + j * 256};
              for (int rep_ = 0; rep_ < ((DUP & 512) ? 2 : 1); ++rep_) { pg8::gemm_phase<EpiNsaIn>(lds, g, S, E); if (DUP & 512) GSYNC(); } }
            GSYNC();
            { pg8::Gemm g{(const bf16_t*)(WSP(p, R_KCV)), (const bf16_t*)(WSP(p, W_CMP1 + j * SZ_CMP1)), 8192, 2048, 256, 1024, 0, 512, 2048, 512}; S.init(8192, 2048, G, bx);
              EpiCmp E{(float*)(WSP(p, R_CMPH))};
              if (PH & 8) pg8::gemm_phase<EpiCmp>(lds, g, S, E); }
            GSYNC();
            if (PH & 16) cmp2_phase(p, j, lds);
            if (DUP & 256) cmp2_phase(p, j, lds);
            GSYNC();
            if (PH & 32) attn_phase(p, lds, j);
            if (DUP & 1) { GSYNC(); attn_phase(p, lds, j); }
            GSYNC();
        } else if (kind == 1) {
            { pg8::Gemm g{HB, (const bf16_t*)(WSP(p, W_RIN)), MTOK, 3328, 2048, 1024, 2048, 0}; S.init(MTOK, 3328, G, bx);
              EpiRwkvIn E{(bf16_t*)(WSP(p, R_RKV)), (bf16_t*)(WSP(p, R_LORAH))};
              for (int rep_ = 0; rep_ < ((DUP & 1024) ? 2 : 1); ++rep_) { pg8::gemm_phase<EpiRwkvIn>(lds, g, S, E); if (DUP & 1024) GSYNC(); } }
            GSYNC();
            { pg8::Gemm g{(const bf16_t*)(WSP(p, R_LORAH)), (const bf16_t*)(WSP(p, W_L2)), MTOK, 3072, 256, 256, 0, 0}; S.init(MTOK, 3072, G, bx);
              EpiLora2 E{(bf16_t*)(WSP(p, R_WAG)), INP(p, 17), INP(p, 20)};
              for (int rep_ = 0; rep_ < ((DUP & 2048) ? 2 : 1); ++rep_) { pg8::gemm_phase<EpiLora2>(lds, g, S, E); if (DUP & 2048) GSYNC(); } }
            GSYNC();
            rwkv_prep_phase(p);
            GSYNC();
            if (PH & 256) scan_phase(p, lds);
            if (DUP & 2) { GSYNC(); scan_phase(p, lds); }
            GSYNC();
            scan_fixup_phase(p, lds);
            GSYNC();
            if (PH & 512) rwkv_gn_phase(p);
            if (DUP & 64) { rwkv_gn_phase(p); rwkv_prep_phase(p); }
            GSYNC();
        } else {
            if (PH & 1024) pool_phase(p);
            if (DUP & 128) pool_phase(p);
            GSYNC();
        }
        {
            pg8::Gemm g; EpiRes E{x, mod + 2048, nullptr, nullptr, layer == 0 ? INP(p, 0) : x};
            if (kind == 0) g = pg8::Gemm{(const bf16_t*)(WSP(p, R_O)), (const bf16_t*)(WSP(p, W_NSA_OUT + j * SZ_SQ)), MTOK, 1024, 1024, 1024, 0, 0};
            else if (kind == 1) g = pg8::Gemm{HA, (const bf16_t*)(WSP(p, W_ROUT)), MTOK, 1024, 1024, 1024, 2048, 0};
            else { g = pg8::Gemm{(const bf16_t*)(WSP(p, R_POOLED)), (const bf16_t*)(WSP(p, W_POOL)), MTOK, 1024, 256, 1024, 0, 512}; E.bias = INP(p, 32); E.pscale = INP(p, 33); }
            S.init(MTOK, 1024, G, bx);
            if (PH & 2048) pg8::gemm_phase<EpiRes>(lds, g, S, E);
        }
        GSYNC();
        if (PH & 2) norm_phase(x, nullptr, HB, INP(p, 5) + layer * DM, mod + 3072, mod + 4096);
        if (DUP & 32) { norm_phase(x, nullptr, HB, INP(p, 5) + layer * DM, mod + 3072, mod + 4096); norm_phase(x, nullptr, HB, INP(p, 5) + layer * DM, mod + 3072, mod + 4096); }
        GSYNC();
        { pg8::Gemm g{HA, (const bf16_t*)(WSP(p, W_GU + layer * SZ_GU)), MTOK, 2 * FF, 1024, 1024, 2048, 0}; S.init(MTOK, 2 * FF, G, bx);
          EpiFfnUp E{(bf16_t*)(WSP(p, R_ACT))};
          if (PH & 4096) pg8::gemm_phase<EpiFfnUp>(lds, g, S, E);
          if (DUP & 4) { GSYNC(); pg8::gemm_phase<EpiFfnUp>(lds, g, S, E); } }
        GSYNC();
        { pg8::Gemm g{(const bf16_t*)(WSP(p, R_ACT)), (const bf16_t*)(WSP(p, W_DN + layer * SZ_DN)), MTOK, 1024, FF, FF, 0, 0}; S.init(MTOK, 1024, G, bx);
          EpiRes E{x, mod + 5120, nullptr, nullptr, x};
          if (PH & 8192) pg8::gemm_phase<EpiRes>(lds, g, S, E); }
        if (layer < 3) GSYNC();
        if (DUP & 8) { for (int r_ = 0; r_ < 8; ++r_) GSYNC(); }
    }
}

extern "C" void kernel_launch(void* const* d_in, const int* in_sizes, int n_in, void* d_out, int out_size, void* d_ws, size_t ws_size, hipStream_t stream) {
    static int grid = 0;
    if (grid == 0) {
        if (n_in != 34 || ws_size < WS_END) { fprintf(stderr, "kernel_launch: unexpected n_in %d or ws_size %zu (need %zu)\n", n_in, ws_size, (size_t)WS_END); grid = -1; return; }
        int dev = 0, cus = 0, per_cu = 0;
        hipGetDevice(&dev); hipDeviceGetAttribute(&cus, hipDeviceAttributeMultiprocessorCount, dev);
        hipFuncSetAttribute((const void*)fwd_kernel, hipFuncAttributeMaxDynamicSharedMemorySize, LDS_BYTES);
        hipOccupancyMaxActiveBlocksPerMultiprocessor(&per_cu, (const void*)fwd_kernel, 512, LDS_BYTES);
        if (per_cu < 1) { fprintf(stderr, "kernel_launch: occupancy query says %d blocks per CU\n", per_cu); per_cu = 1; }
        grid = cus;
    }
    if (grid < 0) return;
    P p{};
    for (int i = 0; i < 34; ++i) p.in[i] = (const float*)d_in[i];
    p.out = (float*)d_out; p.ws = (unsigned char*)d_ws;
    (void)hipMemsetAsync((char*)d_ws + WS_BAR, 0, 16384, stream);
    void* args[] = {&p};
    hipError_t e = hipLaunchCooperativeKernel((const void*)fwd_kernel, dim3(grid), dim3(512), args, LDS_BYTES, stream);
    if (e != hipSuccess) fprintf(stderr, "cooperative launch failed: %s (grid %d)\n", hipGetErrorString(e), grid);
}
```

```cpp
#include <hip/hip_runtime.h>
#include <hip/hip_cooperative_groups.h>
#include <cstdio>
#include <cstdint>
namespace cg = cooperative_groups;

#define DI __device__ __forceinline__
#define LAS __attribute__((address_space(3)))
typedef unsigned short bf16_t;
typedef short bf16x8 __attribute__((ext_vector_type(8)));
typedef float f32x2 __attribute__((ext_vector_type(2)));
typedef float f32x4 __attribute__((ext_vector_type(4)));
typedef float f32x16 __attribute__((ext_vector_type(16)));
typedef unsigned u32x2 __attribute__((ext_vector_type(2)));
typedef unsigned u32x4 __attribute__((ext_vector_type(4)));
typedef __bf16 bf16x2_t __attribute__((ext_vector_type(2)));

constexpr int SEQ = 8192, DM = 1024, MTOK = 16384, FF = 2816;
constexpr int NSA_IN = 2608, NSA_INP = 2816;
constexpr float LOG2E = 1.4426950408889634f;
constexpr float QSCALE = 0.125f * LOG2E;
constexpr float RMS_EPS = 1e-6f;

constexpr size_t MiB = 1u << 20;
constexpr size_t WS_MOD = 0;
constexpr size_t WS_PBIAS = 256 * 1024;
constexpr size_t WS_BAR = 512 * 1024;
constexpr size_t WS_W = 1 * MiB;
constexpr size_t SZ_NSA_IN = (size_t)NSA_INP * 1024 * 2, SZ_SQ = (size_t)1024 * 1024 * 2, SZ_CMP1 = (size_t)256 * 2048 * 2;
constexpr size_t SZ_GU = (size_t)2 * FF * 1024 * 2, SZ_DN = (size_t)1024 * FF * 2, SZ_RIN = (size_t)3328 * 2048 * 2, SZ_L2 = (size_t)3072 * 256 * 2, SZ_POOL = (size_t)1024 * 256 * 2;
constexpr size_t W_NSA_IN = WS_W, W_NSA_OUT = W_NSA_IN + 2 * SZ_NSA_IN, W_CMP1 = W_NSA_OUT + 2 * SZ_SQ, W_GU = W_CMP1 + 2 * SZ_CMP1, W_DN = W_GU + 4 * SZ_GU,
                 W_RIN = W_DN + 4 * SZ_DN, W_L2 = W_RIN + SZ_RIN, W_ROUT = W_L2 + SZ_L2, W_POOL = W_ROUT + SZ_SQ, W_END = W_POOL + SZ_POOL;
static_assert(W_END == 101 * MiB, "weights");
constexpr size_t WS_HB = 101 * MiB;
constexpr size_t WS_R = 136 * MiB;
constexpr size_t R_Q = WS_R, R_KCV = WS_R + 32 * MiB, R_KS = WS_R + 50 * MiB, R_VS = WS_R + 58 * MiB, R_KW = WS_R + 66 * MiB, R_VW = WS_R + 74 * MiB,
                 R_GATES = WS_R + 82 * MiB, R_CMPH = WS_R + 128 * MiB  , R_KCMP = WS_R + 90 * MiB, R_VCMP = WS_R + 91 * MiB, R_O = WS_R + 92 * MiB;
constexpr size_t R_ACT = WS_R;
constexpr size_t R_RKV = WS_R, R_LORAH = WS_R + 96 * MiB, R_WAG = WS_R + 104 * MiB, R_Y = WS_R + 200 * MiB;
constexpr size_t R_POOLED = WS_R;
constexpr size_t WS_END = WS_R + 232 * MiB;

constexpr int LDS_BYTES = 143360;

#ifndef PH
#define PH 0xFFFF
#endif
#ifndef DUP
#define DUP 0
#endif
struct P { const float* in[34]; float* out; unsigned char* ws; };

extern __shared__ __attribute__((aligned(16))) unsigned char lds_raw[];
constexpr int WAVEMAP_OFF = 143360 - 16 - 256;
DI unsigned hw_wave_key() { return (unsigned)__builtin_amdgcn_s_getreg((5 << 11) | 4) & 63u; }
DI int TID() {
    const int w = __builtin_amdgcn_readfirstlane(((volatile LAS int*)((LAS unsigned char*)lds_raw + WAVEMAP_OFF))[hw_wave_key()]);
    unsigned z = 0u; asm volatile("" : "+v"(z));
    int t = w * 64 + (int)__builtin_amdgcn_mbcnt_hi(~0u, __builtin_amdgcn_mbcnt_lo(~0u, z));
    asm volatile("" : "+v"(t)); return t;
}
DI const float* INP(const P& p, int i) { asm volatile("" : "+s"(i)); return p.in[i]; }
DI unsigned char* WSP(const P& p, size_t off) { asm volatile("" : "+s"(off)); return p.ws + off; }
DI unsigned cvtpk(float lo, float hi) { f32x2 v = {lo, hi}; bf16x2_t b = __builtin_convertvector(v, bf16x2_t); return __builtin_bit_cast(unsigned, b); }
DI bf16_t f2bf(float f) { return (bf16_t)(cvtpk(f, 0.f) & 0xffffu); }
DI float bf2f(bf16_t u) { return __uint_as_float(((unsigned)u) << 16); }
DI float wave_sum(float v) {
#pragma unroll
    for (int o = 1; o < 64; o <<= 1) v += __shfl_xor(v, o);
    return v;
}
DI float sigmoidf_(float x) { return 1.f / (1.f + __expf(-x)); }
template <int CTRL> DI int dpp_i(int v) { return __builtin_amdgcn_update_dpp(0, v, CTRL, 0xf, 0xf, false); }
DI int crow(int r, int h) { return (r & 3) + 8 * (r >> 2) + 4 * h; }

namespace pg8 {
constexpr int BM = 256, BK = 64, HALF = 128, HTB = HALF * BK * 2, STAGE_BYTES = 8 * HTB, NXCD = 8, WGM = 8;
DI int lds_byte(int r, int c) { const int st = (r >> 4) * 2 + (c >> 5), rr = r & 15, cc = c & 31, ob = rr * 64 + cc * 2; return st * 1024 + (ob ^ (((ob >> 9) & 1) << 5)); }
DI void stage_rc(int b, int& R, int& C) { const int st = b / 1024, sb = b % 1024, swz = sb ^ (((sb >> 9) & 1) << 5); R = (st >> 1) * 16 + swz / 64; C = (st & 1) * 32 + (swz % 64) / 2; }
struct Unit { int pm, pn; };
struct Gemm { const bf16_t* A; const bf16_t* Bt; int M, N, K, lda; int a_extra; int a_pn; int ldb; int b_pn; };
struct StaticOrder {
    int nM, nN, nwg, G, c;
    DI void init(int M, int N, int G_, int c_) { nM = M / BM; nN = N / BM; nwg = nM * nN; G = G_; c = c_; }
    DI bool next(int i, Unit& u) const {
        const long L = (long)i * G + c; if (L >= nwg) return false;
        int wgid = (int)L; { const int q = nwg / NXCD, r = nwg % NXCD, xcd = wgid % NXCD, off = wgid / NXCD; wgid = (xcd < r ? xcd * (q + 1) : r * (q + 1) + (xcd - r) * q) + off; }
        const int nig = WGM * nN, gid = wgid / nig, fm = gid * WGM, gsz = (nM - fm) < WGM ? (nM - fm) : WGM;
        u.pm = fm + ((wgid % nig) % gsz); u.pn = (wgid % nig) / gsz; return true;
    }
};

template <class Epi>
DI void gemm_phase(LAS unsigned char* lds, const Gemm g, const StaticOrder& S, const Epi& E) {
    const int tid = TID(), wid = __builtin_amdgcn_readfirstlane(tid >> 6), lane = tid & 63, wr = wid >> 2, wc = wid & 3, fr = lane & 15, fq = lane >> 4;
    int K = g.K; asm volatile("" : "+s"(K)); const int nt = K / BK;
    unsigned voffA[2], voffB[2];
    const int ldb = g.ldb ? g.ldb : K;
#pragma unroll
    for (int i = 0; i < 2; ++i) { int R, C; stage_rc(tid * 16 + i * 8192, R, C); voffA[i] = (unsigned)(R * g.lda + C) * 2u; voffB[i] = (unsigned)(R * ldb + C) * 2u; }
    const size_t kstep = (size_t)(BK * 2);
    const size_t hstepA = (size_t)HALF * g.lda * 2, hstepB = (size_t)HALF * ldb * 2;
    const size_t tstepA = 2 * hstepA, tstepB = g.b_pn ? (size_t)g.b_pn : 2 * hstepB;
    const unsigned ldsw = (unsigned)wid * 1024u;
    const int aoff = lds_byte(wr * 64 + fr, fq * 8), boff = lds_byte(wc * 32 + fr, fq * 8);
#define PG8_SA(b, h) (((b) * 2 + (h)) * HTB)
#define PG8_SB(b, h) ((4 + (b) * 2 + (h)) * HTB)
#define PG8_STAGE(bufoff, gbase, voff) do { _Pragma("unroll") for (int _i = 0; _i < 2; ++_i) \
        __builtin_amdgcn_global_load_lds((const unsigned*)((const char*)(gbase) + (voff)[_i]), (LAS unsigned*)(lds + (bufoff) + ldsw + _i * 8192), 16, 0, 0); } while (0)
#define PG8_LDA(dst, b, h) do { _Pragma("unroll") for (int m = 0; m < 4; ++m) _Pragma("unroll") for (int k = 0; k < 2; ++k) dst[m][k] = *(const LAS bf16x8*)(lds + PG8_SA(b, h) + aoff + m * 2048 + k * 1024); } while (0)
#define PG8_LDB(dst, b, h) do { _Pragma("unroll") for (int n = 0; n < 2; ++n) _Pragma("unroll") for (int k = 0; k < 2; ++k) dst[n][k] = *(const LAS bf16x8*)(lds + PG8_SB(b, h) + boff + n * 2048 + k * 1024); } while (0)
#define PG8_MMA(ai, bj, At, Bt) do { __builtin_amdgcn_s_setprio(1); _Pragma("unroll") for (int m = 0; m < 4; ++m) _Pragma("unroll") for (int n = 0; n < 2; ++n) _Pragma("unroll") for (int k = 0; k < 2; ++k) \
        acc[ai][bj][m][n] = __builtin_amdgcn_mfma_f32_16x16x32_bf16(Bt[n][k], At[m][k], acc[ai][bj][m][n], 0, 0, 0); __builtin_amdgcn_s_setprio(0); } while (0)
#define PG8_WAIT_V(n) asm volatile("s_waitcnt vmcnt(" #n ")" ::: "memory")
#define PG8_WAIT_L(n) asm volatile("s_waitcnt lgkmcnt(" #n ")" ::: "memory")
#define PG8_BAR __builtin_amdgcn_s_barrier()
#define PG8_SCHED __builtin_amdgcn_sched_barrier(0)
#define PG8_AOF(u_) ((const char*)g.A + (size_t)(u_).pm * tstepA + (size_t)((u_).pm >> 5) * (size_t)g.a_extra + (size_t)(u_).pn * (size_t)g.a_pn)
    Unit cur, nxt; int ui = 0;
    if (!S.next(0, cur)) return;
    f32x4 acc[2][2][4][2];
#pragma unroll
    for (int a = 0; a < 2; ++a)
#pragma unroll
        for (int b = 0; b < 2; ++b)
#pragma unroll
            for (int m = 0; m < 4; ++m)
#pragma unroll
                for (int n = 0; n < 2; ++n) acc[a][b][m][n] = (f32x4){0.f, 0.f, 0.f, 0.f};
    bf16x8 At[4][2], B0[2][2], B1[2][2];
    const char* cA = PG8_AOF(cur); const char* cB = (const char*)g.Bt + (size_t)cur.pn * tstepB;
    PG8_STAGE(PG8_SB(0, 0), cB, voffB); PG8_STAGE(PG8_SB(0, 1), cB + hstepB, voffB); PG8_STAGE(PG8_SA(0, 0), cA, voffA); PG8_STAGE(PG8_SA(0, 1), cA + hstepA, voffA);
    if (wr == 1) PG8_BAR;
    PG8_WAIT_V(2); PG8_BAR;
    PG8_STAGE(PG8_SB(1, 0), cB + kstep, voffB); PG8_STAGE(PG8_SA(1, 0), cA + kstep, voffA); PG8_STAGE(PG8_SB(1, 1), cB + hstepB + kstep, voffB);
    PG8_WAIT_V(6); PG8_BAR;
    for (;;) {
        const bool has_next = S.next(ui + 1, nxt);
        const char* nA = has_next ? PG8_AOF(nxt) : cA; const char* nB = has_next ? (const char*)g.Bt + (size_t)nxt.pn * tstepB : cB;
        for (int t = 0; t < nt; t += 2) {
            const bool last = (t == nt - 2);
            const char* a1 = cA + (size_t)(t + 1) * kstep;
            const char* a2 = last ? nA : cA + (size_t)(t + 2) * kstep; const char* b2 = last ? nB : cB + (size_t)(t + 2) * kstep;
            const char* a3 = a2 + kstep; const char* b3 = b2 + kstep;
            PG8_LDB(B0, 0, 0); PG8_LDB(B1, 0, 1); PG8_SCHED; PG8_LDA(At, 0, 0); PG8_STAGE(PG8_SA(1, 1), a1 + hstepA, voffA);
            PG8_WAIT_V(8); PG8_WAIT_L(0); PG8_BAR; PG8_MMA(0, 0, At, B0); PG8_MMA(0, 1, At, B1); PG8_BAR; PG8_SCHED;
            PG8_LDA(At, 0, 1); PG8_STAGE(PG8_SB(0, 0), b2, voffB); PG8_STAGE(PG8_SB(0, 1), b2 + hstepB, voffB); PG8_STAGE(PG8_SA(0, 0), a2, voffA);
            PG8_WAIT_V(8); PG8_WAIT_L(0); PG8_BAR; PG8_MMA(1, 0, At, B0); PG8_MMA(1, 1, At, B1); PG8_BAR; PG8_SCHED;
            PG8_LDB(B0, 1, 0); PG8_LDB(B1, 1, 1); PG8_SCHED; PG8_LDA(At, 1, 0); PG8_STAGE(PG8_SA(0, 1), a2 + hstepA, voffA);
            PG8_WAIT_V(8); PG8_WAIT_L(0); PG8_BAR; PG8_MMA(0, 0, At, B0); PG8_MMA(0, 1, At, B1); PG8_BAR; PG8_SCHED;
            PG8_LDA(At, 1, 1); PG8_STAGE(PG8_SB(1, 0), b3, voffB); PG8_STAGE(PG8_SB(1, 1), b3 + hstepB, voffB); PG8_STAGE(PG8_SA(1, 0), a3, voffA);
            PG8_WAIT_V(8); PG8_WAIT_L(0); PG8_BAR; PG8_MMA(1, 0, At, B0); PG8_MMA(1, 1, At, B1); PG8_BAR; PG8_SCHED;
        }
        if (wr == 0) PG8_BAR;
        E(acc, cur, wr, wc, fr, fq);
        if (!has_next) break;
#pragma unroll
        for (int a = 0; a < 2; ++a)
#pragma unroll
            for (int b = 0; b < 2; ++b)
#pragma unroll
                for (int m = 0; m < 4; ++m)
#pragma unroll
                    for (int n = 0; n < 2; ++n) acc[a][b][m][n] = (f32x4){0.f, 0.f, 0.f, 0.f};
        cur = nxt; cA = nA; cB = nB; ++ui;
        if (wr == 1) PG8_BAR;
    }
    PG8_WAIT_V(0);
    PG8_BAR;
#undef PG8_SA
#undef PG8_SB
#undef PG8_STAGE
#undef PG8_LDA
#undef PG8_LDB
#undef PG8_MMA
#undef PG8_WAIT_V
#undef PG8_WAIT_L
#undef PG8_BAR
#undef PG8_SCHED
#undef PG8_AOF
}
}
using pg8::Unit;
typedef f32x4 AccT[2][2][4][2];

DI void st_bf4(bf16_t* p, f32x4 v) { u32x2 w; w.x = cvtpk(v[0], v[1]); w.y = cvtpk(v[2], v[3]); *(u32x2*)p = w; }

struct EpiRes {
    float* x; const float* gate; const float* bias; const float* pscale; const float* xin;
    DI void operator()(const AccT& acc, const Unit& u, int wr, int wc, int fr, int fq) const {
        const int b = u.pm >> 5; const float* gp = gate + b * 6144;
        const int colb = u.pn * 256 + wc * 64 + fq * 4;
        f32x4 g4[2][2], b4[2][2];
#pragma unroll
        for (int bj = 0; bj < 2; ++bj)
#pragma unroll
            for (int n = 0; n < 2; ++n) {
                const int col = colb + bj * 32 + n * 16;
                g4[bj][n] = *(const f32x4*)(gp + col);
                if (bias) { const f32x4 s4 = *(const f32x4*)(pscale + col); g4[bj][n] = g4[bj][n] * s4; b4[bj][n] = *(const f32x4*)(bias + col) * g4[bj][n]; }
                else b4[bj][n] = (f32x4){0.f, 0.f, 0.f, 0.f};
            }
#pragma unroll
        for (int ai = 0; ai < 2; ++ai)
#pragma unroll
            for (int mh = 0; mh < 2; ++mh) {
                f32x4 xv[2][2][2];
#pragma unroll
                for (int m2 = 0; m2 < 2; ++m2) { const float* xr = xin + (size_t)(u.pm * 256 + ai * 128 + wr * 64 + (mh * 2 + m2) * 16 + fr) * DM + colb;
#pragma unroll
                    for (int bj = 0; bj < 2; ++bj)
#pragma unroll
                        for (int n = 0; n < 2; ++n) xv[m2][bj][n] = *(const f32x4*)(xr + bj * 32 + n * 16); }
#pragma unroll
                for (int m2 = 0; m2 < 2; ++m2) { float* xr = x + (size_t)(u.pm * 256 + ai * 128 + wr * 64 + (mh * 2 + m2) * 16 + fr) * DM + colb;
#pragma unroll
                    for (int bj = 0; bj < 2; ++bj)
#pragma unroll
                        for (int n = 0; n < 2; ++n) *(f32x4*)(xr + bj * 32 + n * 16) = xv[m2][bj][n] + g4[bj][n] * acc[ai][bj][mh * 2 + m2][n] + b4[bj][n]; }
                asm volatile("" ::: "memory");
            }
    }
};
struct EpiFfnUp {
    bf16_t* act;
    DI void operator()(const AccT& acc, const Unit& u, int wr, int wc, int fr, int fq) const {
#pragma unroll
        for (int ai = 0; ai < 2; ++ai)
#pragma unroll
            for (int m = 0; m < 4; ++m) {
                const int row = u.pm * 256 + ai * 128 + wr * 64 + m * 16 + fr; bf16_t* ar = act + (size_t)row * FF;
#pragma unroll
                for (int bj = 0; bj < 2; ++bj) {
                    const f32x4 gt = acc[ai][bj][m][0], up = acc[ai][bj][m][1]; f32x4 o;
#pragma unroll
                    for (int j = 0; j < 4; ++j) o[j] = gt[j] * __builtin_amdgcn_rcpf(1.f + __builtin_amdgcn_exp2f(-gt[j] * LOG2E)) * up[j];
                    st_bf4(ar + 16 * (8 * u.pn + 2 * wc + bj) + 4 * fq, o);
                }
            }
    }
};
struct EpiNsaIn {
    bf16_t *Q, *KCV, *KS, *VS, *KW, *VW; float* GATES; const float* qkn;
    DI void operator()(const AccT& acc, const Unit& u, int wr, int wc, int fr, int fq) const {
        const int pn = u.pn, b = u.pm >> 5;
        if (pn >= 10) {
            if (pn > 10 || wc != 0) return;
#pragma unroll
            for (int ai = 0; ai < 2; ++ai)
#pragma unroll
                for (int m = 0; m < 4; ++m) {
                    const int row = u.pm * 256 + ai * 128 + wr * 64 + m * 16 + fr;
#pragma unroll
                    for (int bj = 0; bj < 2; ++bj)
#pragma unroll
                        for (int n = 0; n < 2; ++n) {
                            const int c = bj * 32 + n * 16 + fq * 4;
                            if (c < 48) { f32x4 v = acc[ai][bj][m][n]; f32x4 o;
#pragma unroll
                                for (int j = 0; j < 4; ++j) o[j] = sigmoidf_(v[j]);
                                *(f32x4*)(GATES + (size_t)row * 48 + c) = o; }
                        }
                }
            return;
        }
        const bool nrm = (pn < 4) || pn == 6 || pn == 8;
        const int nidx = pn < 4 ? 0 : (pn == 6 ? 2 : 3);
        const float osc = pn < 4 ? QSCALE : 1.f;
        bf16_t* base; size_t rs;
        if (pn < 4) { base = Q + (size_t)(b * SEQ) * DM + pn * 256 + wc * 64; rs = DM; }
        else { bf16_t* arr = pn == 4 ? KCV : pn == 5 ? KCV + (size_t)8 * 524288 : pn == 6 ? KS : pn == 7 ? VS : pn == 8 ? KW : VW; base = arr + (size_t)(b * 4 + wc) * 524288; rs = 64; }
        f32x4 qw[2][2];
#pragma unroll
        for (int bj = 0; bj < 2; ++bj)
#pragma unroll
            for (int n = 0; n < 2; ++n) qw[bj][n] = nrm ? *(const f32x4*)(qkn + nidx * 64 + bj * 32 + n * 16 + fq * 4) : (f32x4){1.f, 1.f, 1.f, 1.f};
#pragma unroll
        for (int ai = 0; ai < 2; ++ai)
#pragma unroll
            for (int m = 0; m < 4; ++m) {
                const int t = (u.pm & 31) * 256 + ai * 128 + wr * 64 + m * 16 + fr;
                float rstd = 1.f;
                if (nrm) {
                    float ss = 0.f;
#pragma unroll
                    for (int bj = 0; bj < 2; ++bj)
#pragma unroll
                        for (int n = 0; n < 2; ++n) { const f32x4 v = acc[ai][bj][m][n]; ss += (v[0] * v[0] + v[1] * v[1]) + (v[2] * v[2] + v[3] * v[3]); }
                    ss += __shfl_xor(ss, 16); ss += __shfl_xor(ss, 32);
                    rstd = rsqrtf(ss * (1.f / 64.f) + RMS_EPS) * osc;
                }
#pragma unroll
                for (int bj = 0; bj < 2; ++bj)
#pragma unroll
                    for (int n = 0; n < 2; ++n) {
                        const int d = bj * 32 + n * 16 + fq * 4; const f32x4 v = acc[ai][bj][m][n] * rstd * qw[bj][n];
                        st_bf4(base + (size_t)t * rs + d, v);
                    }
            }
    }
};
DI float gelu_tanh(float x) { const float u = 0.7978845608028654f * (x + 0.044715f * x * x * x); const float e = __expf(2.f * u); const float th = 1.f - 2.f / (e + 1.f); return 0.5f * x * (1.f + th); }
struct EpiCmp {
    float* PART;
    DI void operator()(const AccT& acc, const Unit& u, int wr, int wc, int fr, int fq) const {
        const int kv = u.pm >> 4;
        if ((wc >> 1) != kv) return;
        float* base = PART + (size_t)u.pn * 8192 * 128 + (wc & 1) * 64 + fq * 4;
#pragma unroll
        for (int ai = 0; ai < 2; ++ai)
#pragma unroll
            for (int m = 0; m < 4; ++m) {
                const int row = u.pm * 256 + ai * 128 + wr * 64 + m * 16 + fr;
#pragma unroll
                for (int bj = 0; bj < 2; ++bj)
#pragma unroll
                    for (int n = 0; n < 2; ++n) *(f32x4*)(base + (size_t)row * 128 + bj * 32 + n * 16) = acc[ai][bj][m][n];
            }
    }
};
struct EpiRwkvIn {
    bf16_t* RKV; bf16_t* LORAH;
    DI void operator()(const AccT& acc, const Unit& u, int wr, int wc, int fr, int fq) const {
        const int pn = u.pn;
        if (pn < 12) {
            bf16_t* base = RKV + (size_t)(pn >> 2) * MTOK * DM + (pn & 3) * 256 + wc * 64 + fq * 4;
#pragma unroll
            for (int ai = 0; ai < 2; ++ai)
#pragma unroll
                for (int m = 0; m < 4; ++m) {
                    const int row = u.pm * 256 + ai * 128 + wr * 64 + m * 16 + fr;
#pragma unroll
                    for (int bj = 0; bj < 2; ++bj)
#pragma unroll
                        for (int n = 0; n < 2; ++n) st_bf4(base + (size_t)row * DM + bj * 32 + n * 16, acc[ai][bj][m][n]);
                }
        } else {
            bf16_t* base = LORAH + wc * 64 + fq * 4;
#pragma unroll
            for (int ai = 0; ai < 2; ++ai)
#pragma unroll
                for (int m = 0; m < 4; ++m) {
                    const int row = u.pm * 256 + ai * 128 + wr * 64 + m * 16 + fr;
#pragma unroll
                    for (int bj = 0; bj < 2; ++bj)
#pragma unroll
                        for (int n = 0; n < 2; ++n) { const f32x4 v = acc[ai][bj][m][n]; f32x4 o;
#pragma unroll
                            for (int j = 0; j < 4; ++j) { const float z = v[j]; const float sg = __builtin_amdgcn_rcpf(1.f + __builtin_amdgcn_exp2f(-z * (wc == 0 ? 2.f * LOG2E : LOG2E))); o[j] = wc == 0 ? (2.f * sg - 1.f) : (wc == 1 ? z : sg); }
                            st_bf4(base + (size_t)row * 256 + bj * 32 + n * 16, o); }
                    asm volatile("" ::: "memory");
                }
        }
    }
};
struct EpiLora2 {
    bf16_t* WAG; const float* w0; const float* a0;
    DI void operator()(const AccT& acc, const Unit& u, int wr, int wc, int fr, int fq) const {
        const int pn = u.pn, which = pn >> 2;
        const int colb = (pn & 3) * 256 + wc * 64 + fq * 4;
        bf16_t* base = WAG + (size_t)which * MTOK * DM + colb;
        const float* addp = which == 0 ? w0 : a0;
        const float osc = which == 0 ? 0.6065306597126334f : 1.f;
        f32x4 ad[2][2];
#pragma unroll
        for (int bj = 0; bj < 2; ++bj)
#pragma unroll
            for (int n = 0; n < 2; ++n) ad[bj][n] = which < 2 ? *(const f32x4*)(addp + colb + bj * 32 + n * 16) : (f32x4){0.f, 0.f, 0.f, 0.f};
#pragma unroll
        for (int ai = 0; ai < 2; ++ai)
#pragma unroll
            for (int m = 0; m < 4; ++m) {
                const int row = u.pm * 256 + ai * 128 + wr * 64 + m * 16 + fr;
#pragma unroll
                for (int bj = 0; bj < 2; ++bj)
#pragma unroll
                    for (int n = 0; n < 2; ++n) {
                        f32x4 v = acc[ai][bj][m][n]; f32x4 o;
                        if (which < 2) { const f32x4 a4 = ad[bj][n];
#pragma unroll
                            for (int j = 0; j < 4; ++j) o[j] = osc * __builtin_amdgcn_rcpf(1.f + __builtin_amdgcn_exp2f(-(v[j] + a4[j]) * LOG2E)); }
                        else o = v;
                        st_bf4(base + (size_t)row * DM + bj * 32 + n * 16, o);
                    }
                asm volatile("" ::: "memory");
            }
    }
};

DI float wsrc(const P& p, int id, int k, int c) {
    if (id < 2) { const float* W = p.in[9] + (size_t)id * 1024 * NSA_IN; return c < NSA_IN ? W[(size_t)k * NSA_IN + c] : 0.f; }
    if (id < 4) { const float* W = p.in[14] + (size_t)(id - 2) * 1024 * 1024; return W[(size_t)k * 1024 + c]; }
    if (id < 6) { const int kv = c >> 7; const float* W = p.in[11] + (size_t)((id - 4) * 2 + kv) * 2048 * 128; return W[(size_t)k * 128 + (c & 127)]; }
    if (id < 10) { const int grp = c >> 5, w = c & 31, col = grp * 16 + (w & 15); const float* W = ((w >> 4) ? p.in[7] : p.in[6]) + (size_t)(id - 6) * 1024 * FF; return W[(size_t)k * FF + col]; }
    if (id < 14) { const float* W = p.in[8] + (size_t)(id - 10) * FF * 1024; return W[(size_t)k * 1024 + c]; }
    if (id == 14) {
        const int kk = k & 1023; const bool prev = k < 1024; int mi, ldw, cc; const float* W;
        if (c < 3072) { const int which = c >> 10; mi = which == 0 ? 0 : (which == 1 ? 2 : 3); W = p.in[16] + (size_t)which * 1024 * 1024; ldw = 1024; cc = c & 1023; }
        else if (c < 3136) { mi = 1; W = p.in[18]; ldw = 64; cc = c - 3072; }
        else if (c < 3200) { mi = 4; W = p.in[21]; ldw = 64; cc = c - 3136; }
        else { mi = 5; W = p.in[23]; ldw = 128; cc = c - 3200; }
        const float mu = p.in[15][mi * 1024 + kk], w = W[(size_t)kk * ldw + cc];
        return prev ? mu * w : (1.f - mu) * w;
    }
    if (id == 15) {
        if (c < 1024) return k < 64 ? p.in[19][(size_t)k * 1024 + c] : 0.f;
        if (c < 2048) return (k >= 64 && k < 128) ? p.in[22][(size_t)(k - 64) * 1024 + (c - 1024)] : 0.f;
        return k >= 128 ? p.in[24][(size_t)(k - 128) * 1024 + (c - 2048)] : 0.f;
    }
    if (id == 16) return p.in[30][(size_t)k * 1024 + c];
    return p.in[31][(size_t)((c >> 8) * 256 + k) * 256 + (c & 255)];
}
DI void mat_info(int id, int& N, int& K, size_t& off) {
    if (id < 2) { N = NSA_INP; K = 1024; off = W_NSA_IN + id * SZ_NSA_IN; }
    else if (id < 4) { N = 1024; K = 1024; off = W_NSA_OUT + (id - 2) * SZ_SQ; }
    else if (id < 6) { N = 256; K = 2048; off = W_CMP1 + (id - 4) * SZ_CMP1; }
    else if (id < 10) { N = 2 * FF; K = 1024; off = W_GU + (id - 6) * SZ_GU; }
    else if (id < 14) { N = 1024; K = FF; off = W_DN + (id - 10) * SZ_DN; }
    else if (id == 14) { N = 3328; K = 2048; off = W_RIN; }
    else if (id == 15) { N = 3072; K = 256; off = W_L2; }
    else if (id == 16) { N = 1024; K = 1024; off = W_ROUT; }
    else { N = 1024; K = 256; off = W_POOL; }
}
struct ItemSrc { const float* lp; size_t step; const float* mup; bool valid, prev; };
DI ItemSrc item_src(const P& p, int id, int k0, int c0, int lane) {
    ItemSrc it; it.mup = nullptr; it.valid = true; it.prev = false;
    const int c = c0 + lane;
    const float* W; int ldw, col, krow = k0;
    if (id < 2) { W = p.in[9] + (size_t)id * 1024 * NSA_IN; ldw = NSA_IN; col = c; it.valid = c < NSA_IN; }
    else if (id < 4) { W = p.in[14] + (size_t)(id - 2) * 1024 * 1024; ldw = 1024; col = c; }
    else if (id < 6) { W = p.in[11] + (size_t)((id - 4) * 2 + (c >> 7)) * 2048 * 128; ldw = 128; col = c & 127; }
    else if (id < 10) { const int w = c & 31; W = ((w >> 4) ? p.in[7] : p.in[6]) + (size_t)(id - 6) * 1024 * FF; ldw = FF; col = (c >> 5) * 16 + (w & 15); }
    else if (id < 14) { W = p.in[8] + (size_t)(id - 10) * FF * 1024; ldw = 1024; col = c; }
    else if (id == 14) {
        int mi; krow = k0 & 1023; it.prev = k0 < 1024;
        if (c < 3072) { const int which = c >> 10; mi = which == 0 ? 0 : (which == 1 ? 2 : 3); W = p.in[16] + (size_t)which * 1024 * 1024; ldw = 1024; col = c & 1023; }
        else if (c < 3136) { mi = 1; W = p.in[18]; ldw = 64; col = c - 3072; }
        else if (c < 3200) { mi = 4; W = p.in[21]; ldw = 64; col = c - 3136; }
        else { mi = 5; W = p.in[23]; ldw = 128; col = c - 3200; }
        it.mup = p.in[15] + mi * 1024 + krow;
    }
    else if (id == 15) {
        if (c < 1024) { W = p.in[19]; col = c; it.valid = k0 < 64; }
        else if (c < 2048) { W = p.in[22]; col = c - 1024; krow = k0 - 64; it.valid = (k0 >= 64 && k0 < 128); }
        else { W = p.in[24]; col = c - 2048; krow = k0 - 128; it.valid = k0 >= 128; }
        ldw = 1024;
    }
    else if (id == 16) { W = p.in[30]; ldw = 1024; col = c; }
    else { W = p.in[31] + (size_t)(c >> 8) * 65536; ldw = 256; col = c & 255; }
    if (!it.valid) { krow = 0; col = 0; }
    it.lp = W + (size_t)krow * ldw + col; it.step = (size_t)ldw;
    return it;
}
DI void convert_weights(const P& p, LAS unsigned char* lds, unsigned mask, int gw, int NGW, int wave, int lane) {
    LAS float* scr = (LAS float*)(lds + wave * 16896);
    int base = 0;
    for (int id = 0; id < 18; ++id) {
        if (!((mask >> id) & 1u)) continue;
        int N, K; size_t off; mat_info(id, N, K, off);
        const int nblk = N / 64, nitems = (K / 64) * nblk;
        bf16_t* WT = (bf16_t*)(p.ws + off);
        int first = (gw - base % NGW + NGW) % NGW;
        for (int r = first; r < nitems; r += NGW) {
            const int kb = r / nblk, nb = r % nblk, k0 = 64 * kb, tile = nb >> 2, wc = nb & 3;
            const int c0 = 256 * tile + 64 * wc, d0 = 256 * tile + 32 * wc;
            const ItemSrc it = item_src(p, id, k0, c0, lane);
#pragma unroll
            for (int h2 = 0; h2 < 2; ++h2) {
                float tv[32];
#pragma unroll
                for (int i = 0; i < 32; ++i) tv[i] = it.lp[(size_t)(32 * h2 + i) * it.step];
                if (it.mup) {
#pragma unroll
                    for (int i = 0; i < 32; ++i) { const float m = it.mup[32 * h2 + i]; tv[i] *= it.prev ? m : 1.f - m; }
                }
#pragma unroll
                for (int i = 0; i < 32; ++i) scr[(32 * h2 + i) * 65 + lane] = it.valid ? tv[i] : 0.f;
            }
            asm volatile("s_waitcnt lgkmcnt(0)" ::: "memory");
#pragma unroll
            for (int j = 0; j < 8; ++j) { const int cid = lane + 64 * j, n = cid >> 3, cch = cid & 7; const LAS float* sp = scr + (8 * cch) * 65 + n;
                u32x4 o; o.x = cvtpk(sp[0 * 65], sp[1 * 65]); o.y = cvtpk(sp[2 * 65], sp[3 * 65]); o.z = cvtpk(sp[4 * 65], sp[5 * 65]); o.w = cvtpk(sp[6 * 65], sp[7 * 65]);
                *(u32x4*)(WT + (size_t)(d0 + (n & 31) + 128 * (n >> 5)) * K + k0 + 8 * cch) = o; }
            asm volatile("s_waitcnt lgkmcnt(0)" ::: "memory");
        }
        base += nitems;
    }
}
DI void p0_phase(const P& p, LAS unsigned char* lds) {
    const int tid = threadIdx.x, lane = tid & 63, wave = tid >> 6, bi = blockIdx.x;
    LAS float* fl = (LAS float*)lds;
    if (bi < 96) {
        const int layer = bi / 24, n0 = (bi % 24) * 256;
        LAS float* cact = fl; LAS float* red = fl + 2048;
        for (int i = tid; i < 2048; i += 512) { const float cv = p.in[1][i]; cact[i] = cv / (1.f + __expf(-cv)); }
        __syncthreads();
        f32x4 a0 = {0.f, 0.f, 0.f, 0.f}, a1 = a0;
        const float* Wb = p.in[2] + ((size_t)layer * 1024 + wave * 128) * 6144 + n0 + 4 * lane;
        for (int kb = 0; kb < 128; kb += 32) {
            f32x4 wv[32];
#pragma unroll
            for (int k = 0; k < 32; ++k) wv[k] = *(const f32x4*)(Wb + (size_t)(kb + k) * 6144);
#pragma unroll
            for (int k = 0; k < 32; ++k) { const float c0 = cact[wave * 128 + kb + k], c1 = cact[1024 + wave * 128 + kb + k]; a0 += wv[k] * c0; a1 += wv[k] * c1; }
        }
#pragma unroll
        for (int e = 0; e < 4; ++e) { red[(wave * 2 + 0) * 256 + 4 * lane + e] = a0[e]; red[(wave * 2 + 1) * 256 + 4 * lane + e] = a1[e]; }
        __syncthreads();
        { const int b = tid >> 8, col = tid & 255; float s = 0.f;
#pragma unroll
          for (int w = 0; w < 8; ++w) s += red[(w * 2 + b) * 256 + col];
          ((float*)(p.ws + WS_MOD))[(size_t)(layer * 2 + b) * 6144 + n0 + col] = s + p.in[3][(size_t)layer * 6144 + n0 + col]; }
        __syncthreads();
    } else if (bi < 100) {
        const int it = bi - 96; const float* pos = p.in[10] + (size_t)it * 2048; const float* w1 = p.in[11] + (size_t)it * 2048 * 128;
        const int c = tid & 127, ks = tid >> 7; float s = 0.f;
        for (int kb = ks * 512; kb < ks * 512 + 512; kb += 32) {
            float wv[32];
#pragma unroll
            for (int k = 0; k < 32; ++k) wv[k] = w1[(size_t)(kb + k) * 128 + c];
#pragma unroll
            for (int k = 0; k < 32; ++k) s += pos[kb + k] * wv[k];
        }
        fl[ks * 128 + c] = s; __syncthreads();
        if (tid < 128) ((float*)(p.ws + WS_PBIAS))[it * 128 + tid] = (fl[tid] + fl[128 + tid]) + (fl[256 + tid] + fl[384 + tid]);
        __syncthreads();
    } else if (bi == 100) {
        unsigned* hb = (unsigned*)(p.ws + WS_HB);
        hb[tid] = 0u; hb[(size_t)8193 * 512 + tid] = 0u;
    }
    convert_weights(p, lds, 0x3FFFFu, bi * 8 + wave, gridDim.x * 8, wave, lane);
}

DI void norm_phase(const float* xs, float* xcopy, bf16_t* HB, const float* nw, const float* shift, const float* scale) {
    const int tid_ = TID(), lane = tid_ & 63, gw = blockIdx.x * 8 + (tid_ >> 6), NGW = gridDim.x * 8;
    f32x4 w4[4];
#pragma unroll
    for (int j = 0; j < 4; ++j) w4[j] = *(const f32x4*)(nw + 4 * lane + 256 * j);
    for (int m = gw; m < MTOK; m += 2 * NGW) {
        const int m1 = m + NGW;
        const bool has1 = m1 < MTOK;
        const f32x4* xr0 = (const f32x4*)(xs + (size_t)m * DM) + lane;
        const f32x4* xr1 = (const f32x4*)(xs + (size_t)(has1 ? m1 : m) * DM) + lane;
        f32x4 v0[4], v1[4];
#pragma unroll
        for (int j = 0; j < 4; ++j) v0[j] = xr0[64 * j];
#pragma unroll
        for (int j = 0; j < 4; ++j) v1[j] = xr1[64 * j];
        float ss0 = 0.f, ss1 = 0.f;
#pragma unroll
        for (int j = 0; j < 4; ++j) { ss0 += (v0[j][0] * v0[j][0] + v0[j][1] * v0[j][1]) + (v0[j][2] * v0[j][2] + v0[j][3] * v0[j][3]);
                                      ss1 += (v1[j][0] * v1[j][0] + v1[j][1] * v1[j][1]) + (v1[j][2] * v1[j][2] + v1[j][3] * v1[j][3]); }
#pragma unroll
        for (int o = 1; o < 64; o <<= 1) { ss0 += __shfl_xor(ss0, o); ss1 += __shfl_xor(ss1, o); }
        const float rstd0 = rsqrtf(ss0 * (1.f / DM) + RMS_EPS), rstd1 = rsqrtf(ss1 * (1.f / DM) + RMS_EPS);
        if (xcopy) { f32x4* xo = (f32x4*)(xcopy + (size_t)m * DM) + lane;
#pragma unroll
            for (int j = 0; j < 4; ++j) xo[64 * j] = v0[j];
            if (has1) { f32x4* xo1 = (f32x4*)(xcopy + (size_t)m1 * DM) + lane;
#pragma unroll
                for (int j = 0; j < 4; ++j) xo1[64 * j] = v1[j]; } }
        { const int b = m >> 13; bf16_t* ho = HB + (size_t)(m + 1 + b) * DM;
#pragma unroll
          for (int j = 0; j < 4; ++j) { const int col = 4 * lane + 256 * j;
              const f32x4 sc4 = *(const f32x4*)(scale + b * 6144 + col), sh4 = *(const f32x4*)(shift + b * 6144 + col);
              st_bf4(ho + col, (v0[j] * rstd0) * w4[j] * (sc4 + 1.f) + sh4); } }
        if (has1) { const int b = m1 >> 13; bf16_t* ho = HB + (size_t)(m1 + 1 + b) * DM;
#pragma unroll
          for (int j = 0; j < 4; ++j) { const int col = 4 * lane + 256 * j;
              const f32x4 sc4 = *(const f32x4*)(scale + b * 6144 + col), sh4 = *(const f32x4*)(shift + b * 6144 + col);
              st_bf4(ho + col, (v1[j] * rstd1) * w4[j] * (sc4 + 1.f) + sh4); } }
    }
}

DI void cmp2_phase(const P& p, int j, LAS unsigned char* lds) {
    const int tid_ = TID(), lane = tid_ & 63, wave = tid_ >> 6, gw = blockIdx.x * 8 + wave, NGW = gridDim.x * 8;
    const float* CMPH = (const float*)(WSP(p, R_CMPH));
    const float* pbp = (const float*)(WSP(p, WS_PBIAS)) + j * 256;
    const float* w2b = INP(p, 12) + (size_t)(j * 2) * 128 * 64; const float* qn1 = INP(p, 13) + (size_t)(j * 4 + 1) * 64;
    bf16_t* KCo = (bf16_t*)(WSP(p, R_KCMP)); bf16_t* VCo = (bf16_t*)(WSP(p, R_VCMP));
    LAS float* w2s = (LAS float*)lds;
    LAS float* hrow = (LAS float*)(lds + 65536) + wave * 128;
    for (int e = tid_; e < 2 * 128 * 64; e += 512) w2s[e] = w2b[e];
    __syncthreads();
    for (int row = gw; row < 8192; row += NGW) {
        const int slab = row >> 9, n = row & 511, kv = slab >> 3;
        f32x2 hp[8];
#pragma unroll
        for (int ks = 0; ks < 8; ++ks) hp[ks] = *(const f32x2*)(CMPH + (size_t)ks * 8192 * 128 + (size_t)row * 128 + 2 * lane);
        f32x2 h2 = *(const f32x2*)(pbp + kv * 128 + 2 * lane);
#pragma unroll
        for (int ks = 0; ks < 8; ++ks) h2 = h2 + hp[ks];
        hrow[2 * lane] = gelu_tanh(h2[0]); hrow[2 * lane + 1] = gelu_tanh(h2[1]);
        asm volatile("s_waitcnt lgkmcnt(0)" ::: "memory");
        const LAS float* w2 = w2s + kv * 8192 + lane;
        float a0 = 0.f, a1 = 0.f;
#pragma unroll 16
        for (int c = 0; c < 128; c += 2) { a0 += hrow[c] * w2[c * 64]; a1 += hrow[c + 1] * w2[(c + 1) * 64]; }
        const float acc = a0 + a1;
        float o = acc;
        if (kv == 0) { const float ss = wave_sum(acc * acc); o = acc * rsqrtf(ss * (1.f / 64.f) + RMS_EPS) * qn1[lane]; }
        if (n == 511) o = 0.f;
        bf16_t* dst = (kv == 0 ? KCo : VCo) + (size_t)(slab & 7) * 512 * 64 + (size_t)n * 64 + lane;
        *dst = f2bf(o);
        asm volatile("s_waitcnt lgkmcnt(0)" ::: "memory");
    }
}

constexpr int A_KT = 0, A_VT = 9216, A_BUF = 18432, A_IMP = 2 * A_BUF, A_SELM = A_IMP + 64 * 129 * 4, A_UNI = A_SELM + 1024, A_OAS = A_UNI + 16, A_END = A_OAS + 65536;
static_assert(A_END <= 143360 - 16 - 256, "attention LDS");
#define ABAR() do { asm volatile("s_waitcnt lgkmcnt(0)" ::: "memory"); __builtin_amdgcn_s_barrier(); asm volatile("" ::: "memory"); } while (0)
#define MFMA32(a, b, c) __builtin_amdgcn_mfma_f32_32x32x16_bf16((a), (b), (c), 0, 0, 0)
DI float xhalf_max(float v) { auto rr = __builtin_amdgcn_permlane32_swap(__float_as_uint(v), __float_as_uint(v), false, false); return fmaxf(__uint_as_float(rr[0]), __uint_as_float(rr[1])); }
DI float xhalf_other(float v, int hi) { auto rr = __builtin_amdgcn_permlane32_swap(__float_as_uint(v), __float_as_uint(v), false, false); return __uint_as_float(hi ? rr[0] : rr[1]); }
DI float xhalf_sum(float v) { auto rr = __builtin_amdgcn_permlane32_swap(__float_as_uint(v), __float_as_uint(v), false, false); return __uint_as_float(rr[0]) + __uint_as_float(rr[1]); }

struct KVRegs { u32x4 k, v; };
DI void kv_load(KVRegs& r, const bf16_t* Kg, const bf16_t* Vg, int tid) {
    r.k = *(const u32x4*)(Kg + tid * 8);
    if (Vg) r.v = *(const u32x4*)(Vg + (tid & 63) * 64 + (tid >> 6) * 8);
}
DI void kv_store(const KVRegs& r, LAS unsigned char* lds, int tid, bool hasv) {
    const int row = tid >> 3, ch = tid & 7;
    *(LAS u32x4*)(lds + A_KT + row * 144 + ch * 16) = r.k;
    if (hasv) {
        LAS bf16_t* vt = (LAS bf16_t*)(lds + A_VT); const int key = tid & 63, dch = tid >> 6;
#pragma unroll
        for (int e = 0; e < 4; ++e) { const unsigned w = r.v[e]; vt[(dch * 8 + 2 * e) * 68 + key] = (bf16_t)(w & 0xffffu); vt[(dch * 8 + 2 * e + 1) * 68 + key] = (bf16_t)(w >> 16); }
    }
}
DI void tile_scores(f32x16& s0, f32x16& s1, const LAS unsigned char* lds, const bf16x8 (&qr)[4], float bb, float cstep, int r32, int hi) {
    asm volatile("" : "+v"(hi), "+v"(r32));
    const float bb2 = bb + cstep * (float)(4 * hi);
#pragma unroll
    for (int i = 0; i < 16; ++i) { s0[i] = fmaf(cstep, (float)((i & 3) + 8 * (i >> 2)), bb2); s1[i] = fmaf(cstep, (float)((i & 3) + 8 * (i >> 2) + 32), bb2); }
    const LAS unsigned char* kp = lds + A_KT + r32 * 144 + hi * 16;
#pragma unroll
    for (int s = 0; s < 4; ++s) {
        const bf16x8 a0 = *(const LAS bf16x8*)(kp + s * 32), a1 = *(const LAS bf16x8*)(kp + 32 * 144 + s * 32);
        s0 = MFMA32(a0, qr[s], s0); s1 = MFMA32(a1, qr[s], s1);
    }
}
DI void mask_range(f32x16& s0, f32x16& s1, int klo, int khi, int hi) {
    asm volatile("" : "+v"(hi));
#pragma unroll
    for (int i = 0; i < 16; ++i) { const int k = crow(i, hi); s0[i] = (k >= klo && k <= khi) ? s0[i] : -INFINITY; s1[i] = (k + 32 >= klo && k + 32 <= khi) ? s1[i] : -INFINITY; }
}
DI void mask_le(f32x16& s0, f32x16& s1, int khi, int hi) {
    asm volatile("" : "+v"(hi));
    const int kh = khi - 4 * hi;
#pragma unroll
    for (int i = 0; i < 16; ++i) { const int k = (i & 3) + 8 * (i >> 2); s0[i] = (k <= kh) ? s0[i] : -INFINITY; s1[i] = (k + 32 <= kh) ? s1[i] : -INFINITY; }
}
DI void mask_ge(f32x16& s0, f32x16& s1, int klo, int hi) {
    asm volatile("" : "+v"(hi));
    const int kl = klo - 4 * hi;
#pragma unroll
    for (int i = 0; i < 16; ++i) { const int k = (i & 3) + 8 * (i >> 2); s0[i] = (k >= kl) ? s0[i] : -INFINITY; s1[i] = (k + 32 >= kl) ? s1[i] : -INFINITY; }
}
DI void mask_lane(f32x16& s0, f32x16& s1, bool keep) {
#pragma unroll
    for (int i = 0; i < 16; ++i) { s0[i] = keep ? s0[i] : -INFINITY; s1[i] = keep ? s1[i] : -INFINITY; }
}
DI float tile_max(const f32x16& s0, const f32x16& s1) {
    float a = fmaxf(s0[0], s1[0]);
#pragma unroll
    for (int i = 1; i < 16; ++i) a = fmaxf(a, fmaxf(s0[i], s1[i]));
    return xhalf_max(a);
}
DI void pv_tile(f32x16& o0, f32x16& o1, const f32x16& p0, const f32x16& p1, const LAS unsigned char* lds, int r32, int hi) {
    asm volatile("" : "+v"(hi), "+v"(r32));
    const LAS unsigned char* vp = lds + A_VT;
#pragma unroll
    for (int kh = 0; kh < 2; ++kh) {
        u32x4 av[2][2];
#pragma unroll
        for (int k2 = 0; k2 < 2; ++k2) { const int kb = 16 * (2 * kh + k2) + 4 * hi;
#pragma unroll
            for (int dt = 0; dt < 2; ++dt) { const LAS unsigned char* a = vp + ((32 * dt + r32) * 68 + kb) * 2;
                const u32x2 lo = *(const LAS u32x2*)a, hi8 = *(const LAS u32x2*)(a + 16); av[k2][dt] = (u32x4){lo.x, lo.y, hi8.x, hi8.y}; } }
        __builtin_amdgcn_sched_barrier(0x7);
#pragma unroll
        for (int k2 = 0; k2 < 2; ++k2) {
            const f32x16& pp = kh == 0 ? p0 : p1; const int o8 = 8 * k2;
            u32x4 pw; pw.x = cvtpk(pp[o8 + 0], pp[o8 + 1]); pw.y = cvtpk(pp[o8 + 2], pp[o8 + 3]); pw.z = cvtpk(pp[o8 + 4], pp[o8 + 5]); pw.w = cvtpk(pp[o8 + 6], pp[o8 + 7]);
            const bf16x8 pb = __builtin_bit_cast(bf16x8, pw);
            o0 = MFMA32(__builtin_bit_cast(bf16x8, av[k2][0]), pb, o0); o1 = MFMA32(__builtin_bit_cast(bf16x8, av[k2][1]), pb, o1);
        }
    }
}
DI void online_step(float& m, float& l, f32x16& o0, f32x16& o1, f32x16& s0, f32x16& s1) {
    const float mx = tile_max(s0, s1);
    const float mn = fmaxf(m, mx);
    const float mu = (mn == -INFINITY) ? 0.f : mn;
    const float alpha = __builtin_amdgcn_exp2f(m - mu);
    float ls = 0.f;
#pragma unroll
    for (int i = 0; i < 16; ++i) { s0[i] = __builtin_amdgcn_exp2f(s0[i] - mu); s1[i] = __builtin_amdgcn_exp2f(s1[i] - mu); ls += s0[i] + s1[i]; }
    l = l * alpha + ls;
#pragma unroll
    for (int i = 0; i < 16; ++i) { o0[i] *= alpha; o1[i] *= alpha; }
    m = mn;
}

typedef float f32x8 __attribute__((ext_vector_type(8)));
DI void fixed_step(float& l, f32x16& s0, f32x16& s1) {
#pragma unroll
    for (int i = 0; i < 16; ++i) { s0[i] = __builtin_amdgcn_exp2f(s0[i]); s1[i] = __builtin_amdgcn_exp2f(s1[i]); }
    const f32x16 v = s0 + s1;
    const f32x8 a8 = __builtin_shufflevector(v, v, 0, 1, 2, 3, 4, 5, 6, 7) + __builtin_shufflevector(v, v, 8, 9, 10, 11, 12, 13, 14, 15);
    const f32x4 a4 = __builtin_shufflevector(a8, a8, 0, 1, 2, 3) + __builtin_shufflevector(a8, a8, 4, 5, 6, 7);
    const f32x2 a2 = __builtin_shufflevector(a4, a4, 0, 1) + __builtin_shufflevector(a4, a4, 2, 3);
    l += a2[0] + a2[1];
}
DI void stats_step(float& m, float& l, const f32x16& s0, const f32x16& s1) {
    const float mx = tile_max(s0, s1);
    const float mn = fmaxf(m, mx);
    const float mu = (mn == -INFINITY) ? 0.f : mn;
    float ls = 0.f;
#pragma unroll
    for (int i = 0; i < 16; ++i) ls += __builtin_amdgcn_exp2f(s0[i] - mu) + __builtin_amdgcn_exp2f(s1[i] - mu);
    l = l * __builtin_amdgcn_exp2f(m - mu) + ls;
    m = mn;
}
DI void attn_phase(const P& p, LAS unsigned char* lds, int jl) {
    const int tid = TID(), lane = tid & 63, wid = __builtin_amdgcn_readfirstlane(tid >> 6), r32 = lane & 31, hi = lane >> 5;
    const int hh = wid & 3, qh = wid >> 2;
    float wmx[3];
    { const float* qn_ = INP(p, 13) + jl * 256;
#pragma unroll
      for (int ix = 0; ix < 3; ++ix) { float v = fabsf(qn_[(ix + 1) * 64 + lane]);
#pragma unroll
          for (int o = 1; o < 64; o <<= 1) v = fmaxf(v, __shfl_xor(v, o));
          wmx[ix] = __int_as_float(__builtin_amdgcn_readfirstlane(__float_as_int(v))); } }
    const bf16_t* Q = (const bf16_t*)(WSP(p, R_Q));
    const bf16_t* KS = (const bf16_t*)(WSP(p, R_KS)); const bf16_t* VS = (const bf16_t*)(WSP(p, R_VS));
    const bf16_t* KW = (const bf16_t*)(WSP(p, R_KW)); const bf16_t* VW = (const bf16_t*)(WSP(p, R_VW));
    const bf16_t* KC = (const bf16_t*)(WSP(p, R_KCMP)); const bf16_t* VC = (const bf16_t*)(WSP(p, R_VCMP));
    const float* GATES = (const float*)(WSP(p, R_GATES));
    bf16_t* O = (bf16_t*)(WSP(p, R_O));
    LAS float* IMP = (LAS float*)(lds + A_IMP);
    LAS unsigned* SELM = (LAS unsigned*)(lds + A_SELM);
    LAS unsigned* UNI = (LAS unsigned*)(lds + A_UNI);
    LAS float* OAS = (LAS float*)(lds + A_OAS) + tid;

    for (int u = blockIdx.x; u < 1024; u += gridDim.x) {
        const int bg = u & 7, rr_ = u >> 3, kq = rr_ >> 5, wq = rr_ & 31, qb = 32 * kq + ((kq & 1) ? 31 - wq : wq);
        const int b = bg >> 2, g = bg & 3, head = g * 4 + hh, qloc = qh * 32 + r32, t = qb * 64 + qloc, tref = qb * 64;
        const float slope2 = exp2f(-0.5f * (float)(head + 1)) * LOG2E;
        bf16x8 qr[4];
        { const bf16_t* qp = Q + ((size_t)(b * SEQ + t)) * DM + head * 64 + hi * 8;
#pragma unroll
          for (int s = 0; s < 4; ++s) qr[s] = *(const bf16x8*)(qp + s * 16); }
        float qn2 = 0.f;
#pragma unroll
        for (int s_ = 0; s_ < 4; ++s_)
#pragma unroll
            for (int e = 0; e < 8; ++e) { const float x = __uint_as_float(((unsigned)(unsigned short)qr[s_][e]) << 16); qn2 += x * x; }
        const float qnb = sqrtf(xhalf_sum(qn2)) * (8.f * 1.02f);
        for (int i = tid; i < 64 * 129; i += 512) IMP[i] = 0.f;
        if (tid < 256) SELM[tid] = 0u;
        if (tid < 4) UNI[tid] = 0u;
        const size_t bgoff = (size_t)(b * 4 + g);
        KVRegs kr;
        const int ncmp = 4 * qb + 3;
        const int ncb = (ncmp + 63) >> 6;
        const int nmaxq = (t - 31) >> 4;
        const bf16_t* KCb = KC + bgoff * 512 * 64; const bf16_t* VCb = VC + bgoff * 512 * 64;
        float lc = 0.f;
        {
            __syncthreads();
            kv_load(kr, KCb, nullptr, tid); kv_store(kr, lds, tid, false);
            if (ncb > 1) kv_load(kr, KCb + 4096, nullptr, tid);
            ABAR();
            for (int cb = 0; cb < ncb; ++cb) {
                LAS unsigned char* lb = lds + (cb & 1) * A_BUF;
                if (cb + 1 < ncb) { kv_store(kr, lds + ((cb + 1) & 1) * A_BUF, tid, false); if (cb + 2 < ncb) kv_load(kr, KCb + (size_t)(cb + 2) * 4096, nullptr, tid); }
                f32x16 s0, s1;
                tile_scores(s0, s1, lb, qr, slope2 * (float)(1024 * cb + 31 - tref) - (slope2 * (float)qloc + qnb * wmx[0]), slope2 * 16.f, r32, hi);
                mask_le(s0, s1, nmaxq - 64 * cb, hi);
                fixed_step(lc, s0, s1);
                ABAR();
            }
            lc = xhalf_sum(lc);
        }
        {
            const float rl = lc > 0.f ? 1.f / lc : 0.f; const float gate_c = (GATES + (size_t)(b * SEQ + t) * 48 + head)[0];
            float carry = 0.f;
            f32x16 oa0, oa1;
#pragma unroll
            for (int i = 0; i < 16; ++i) { oa0[i] = 0.f; oa1[i] = 0.f; }
            kv_load(kr, KCb, VCb, tid); kv_store(kr, lds, tid, true);
            if (ncb > 1) kv_load(kr, KCb + 4096, VCb + 4096, tid);
            ABAR();
            for (int cb = 0; cb < ncb; ++cb) {
                LAS unsigned char* lb = lds + (cb & 1) * A_BUF;
                if (cb + 1 < ncb) { kv_store(kr, lds + ((cb + 1) & 1) * A_BUF, tid, true); if (cb + 2 < ncb) kv_load(kr, KCb + (size_t)(cb + 2) * 4096, VCb + (size_t)(cb + 2) * 4096, tid); }
                f32x16 s0, s1;
                tile_scores(s0, s1, lb, qr, slope2 * (float)(1024 * cb + 31 - tref) - (slope2 * (float)qloc + qnb * wmx[0]), slope2 * 16.f, r32, hi);
                mask_le(s0, s1, nmaxq - 64 * cb, hi);
#pragma unroll
                for (int i = 0; i < 16; ++i) { s0[i] = __builtin_amdgcn_exp2f(s0[i]) * rl; s1[i] = __builtin_amdgcn_exp2f(s1[i]) * rl; }
                float g4[8], pl[8];
#pragma unroll
                for (int ib = 0; ib < 4; ++ib) { g4[ib] = (s0[4 * ib] + s0[4 * ib + 1]) + (s0[4 * ib + 2] + s0[4 * ib + 3]); pl[ib] = s0[4 * ib + 3];
                                                 g4[4 + ib] = (s1[4 * ib] + s1[4 * ib + 1]) + (s1[4 * ib + 2] + s1[4 * ib + 3]); pl[4 + ib] = s1[4 * ib + 3]; }
                float ppl[8], add[8];
#pragma unroll
                for (int q8 = 0; q8 < 8; ++q8) ppl[q8] = xhalf_other(pl[q8], hi);
#pragma unroll
                for (int q8 = 0; q8 < 8; ++q8) add[q8] = hi ? ppl[q8] : (q8 > 0 ? ppl[q8 - 1] : carry);
                carry = ppl[7];
#pragma unroll
                for (int i = 0; i < 16; ++i) { s0[i] *= gate_c; s1[i] *= gate_c; }
                pv_tile(oa0, oa1, s0, s1, lb, r32, hi);
                for (int turn = 0; turn < 4; ++turn) {
                    if (hh == turn) {
#pragma unroll
                        for (int q8 = 0; q8 < 8; ++q8) { const int j0 = 16 * cb + 2 * q8 + hi; if (j0 < 128) IMP[qloc * 129 + j0] += g4[q8] + add[q8]; }
                    }
                    ABAR();
                }
            }
#pragma unroll
            for (int i = 0; i < 16; ++i) { OAS[i * 512] = oa0[i]; OAS[(16 + i) * 512] = oa1[i]; }
        }
        __syncthreads();
        {
            const int q = tid >> 3, part = tid & 7;
            int val[16]; unsigned mysel = 0u;
#pragma unroll
            for (int e = 0; e < 16; ++e) { const int j = part * 16 + e; val[e] = (j >= 1 && j <= qb - 2) ? __float_as_int(IMP[q * 129 + j]) : -1; }
            const int nf = qb == 0 ? 1 : (qb == 1 ? 2 : 3);
            for (int round = 0; round < 16 - nf; ++round) {
                int lm = val[0];
#pragma unroll
                for (int e = 1; e < 16; ++e) lm = max(lm, val[e]);
                lm = max(lm, dpp_i<0xB1>(lm)); lm = max(lm, dpp_i<0x4E>(lm)); lm = max(lm, dpp_i<0x141>(lm));
                int jm = 255;
#pragma unroll
                for (int e = 0; e < 16; ++e) jm = (val[e] == lm) ? min(jm, part * 16 + e) : jm;
                jm = min(jm, dpp_i<0xB1>(jm)); jm = min(jm, dpp_i<0x4E>(jm)); jm = min(jm, dpp_i<0x141>(jm));
                if (lm >= 0) {
#pragma unroll
                    for (int e = 0; e < 16; ++e) if (part * 16 + e == jm) { val[e] = -1; mysel |= 1u << e; }
                }
            }
#pragma unroll
            for (int e = 0; e < 16; ++e) { const int j = part * 16 + e; if (j == 0 || j == qb || j == qb - 1) mysel |= 1u << e; }
            if (mysel) { const unsigned w = mysel << ((part & 1) * 16); atomicOr((unsigned*)&SELM[q * 4 + (part >> 1)], w); atomicOr((unsigned*)&UNI[part >> 1], w); }
        }
        __syncthreads();
        {
            const unsigned sw0 = SELM[qloc * 4 + 0], sw1 = SELM[qloc * 4 + 1], sw2 = SELM[qloc * 4 + 2], sw3 = SELM[qloc * 4 + 3];
            const unsigned un0 = UNI[0], un1 = UNI[1], un2 = UNI[2], un3 = UNI[3];
            float ls = 0.f; f32x16 o0, o1;
#pragma unroll
            for (int i = 0; i < 16; ++i) { o0[i] = 0.f; o1[i] = 0.f; }
            const bf16_t* Kb = KS + bgoff * 524288; const bf16_t* Vb = VS + bgoff * 524288;
            auto ubit = [&](int j) -> bool { const unsigned w = (j >> 5) == 0 ? un0 : ((j >> 5) == 1 ? un1 : ((j >> 5) == 2 ? un2 : un3)); return (w >> (j & 31)) & 1u; };
            int j = 0, it = 0;
            int jn = 1; while (jn <= qb && !ubit(jn)) ++jn;
            kv_load(kr, Kb, Vb, tid); kv_store(kr, lds, tid, true);
            if (jn <= qb) kv_load(kr, Kb + (size_t)jn * 4096, Vb + (size_t)jn * 4096, tid);
            ABAR();
            while (j <= qb) {
                LAS unsigned char* lb = lds + (it & 1) * A_BUF;
                int jnn = jn + 1; while (jnn <= qb && !ubit(jnn)) ++jnn;
                if (jn <= qb) { kv_store(kr, lds + ((it + 1) & 1) * A_BUF, tid, true); if (jnn <= qb) kv_load(kr, Kb + (size_t)jnn * 4096, Vb + (size_t)jnn * 4096, tid); }
                const unsigned w = (j >> 5) == 0 ? sw0 : ((j >> 5) == 1 ? sw1 : ((j >> 5) == 2 ? sw2 : sw3));
                const bool sel = (w >> (j & 31)) & 1u;
                if (__any(sel)) {
                    f32x16 s0, s1;
                    tile_scores(s0, s1, lb, qr, sel ? slope2 * (float)(64 * j - tref) - (slope2 * (float)qloc + qnb * wmx[1]) : -INFINITY, slope2, r32, hi);
                    if (j == qb) mask_le(s0, s1, qloc, hi);
                    fixed_step(ls, s0, s1);
                    pv_tile(o0, o1, s0, s1, lb, r32, hi);
                }
                ABAR();
                j = jn; jn = jnn; ++it;
            }
            ls = xhalf_sum(ls);
            const float f = (GATES + (size_t)(b * SEQ + t) * 48 + head)[16] * (ls > 0.f ? 1.f / ls : 0.f);
#pragma unroll
            for (int i = 0; i < 16; ++i) { OAS[i * 512] += f * o0[i]; OAS[(16 + i) * 512] += f * o1[i]; }
        }
        {
            float lw = 0.f; f32x16 o0, o1;
#pragma unroll
            for (int i = 0; i < 16; ++i) { o0[i] = 0.f; o1[i] = 0.f; }
            const bf16_t* Kb = KW + bgoff * 524288; const bf16_t* Vb = VW + bgoff * 524288;
            const int j0 = qb >= 8 ? qb - 8 : 0;
            kv_load(kr, Kb + (size_t)j0 * 4096, Vb + (size_t)j0 * 4096, tid); kv_store(kr, lds, tid, true);
            if (j0 + 1 <= qb) kv_load(kr, Kb + (size_t)(j0 + 1) * 4096, Vb + (size_t)(j0 + 1) * 4096, tid);
            ABAR();
            for (int j = j0; j <= qb; ++j) {
                LAS unsigned char* lb = lds + ((j - j0) & 1) * A_BUF;
                if (j + 1 <= qb) { kv_store(kr, lds + ((j - j0 + 1) & 1) * A_BUF, tid, true); if (j + 2 <= qb) kv_load(kr, Kb + (size_t)(j + 2) * 4096, Vb + (size_t)(j + 2) * 4096, tid); }
                f32x16 s0, s1;
                tile_scores(s0, s1, lb, qr, slope2 * (float)(64 * j - tref) - (slope2 * (float)qloc + qnb * wmx[2]), slope2, r32, hi);
                if (j == qb) mask_le(s0, s1, qloc, hi);
                else if (j == qb - 8) mask_ge(s0, s1, qloc + 1, hi);
                fixed_step(lw, s0, s1);
                pv_tile(o0, o1, s0, s1, lb, r32, hi);
                ABAR();
            }
            lw = xhalf_sum(lw);
            const float f = (GATES + (size_t)(b * SEQ + t) * 48 + head)[32] * (lw > 0.f ? 1.f / lw : 0.f);
            f32x16 oa0, oa1;
#pragma unroll
            for (int i = 0; i < 16; ++i) { oa0[i] = OAS[i * 512] + f * o0[i]; oa1[i] = OAS[(16 + i) * 512] + f * o1[i]; }
          bf16_t* op = O + (size_t)(b * SEQ + t) * DM + head * 64 + 4 * hi;
#pragma unroll
          for (int ib = 0; ib < 4; ++ib) {
              st_bf4(op + 8 * ib, (f32x4){oa0[4 * ib], oa0[4 * ib + 1], oa0[4 * ib + 2], oa0[4 * ib + 3]});
              st_bf4(op + 32 + 8 * ib, (f32x4){oa1[4 * ib], oa1[4 * ib + 1], oa1[4 * ib + 2], oa1[4 * ib + 3]}); } }
        __syncthreads();
    }
}

template <int CTRL> DI float dpp_f(float v) { return __int_as_float(__builtin_amdgcn_update_dpp(0, __float_as_int(v), CTRL, 0xf, 0xf, false)); }
DI float allreduce16(float v) { v += dpp_f<0xB1>(v); v += dpp_f<0x4E>(v); v += dpp_f<0x141>(v); v += dpp_f<0x140>(v); return v; }
DI void unpack8(const u32x4& w, float* f) {
#pragma unroll
    for (int e = 0; e < 4; ++e) { f[2 * e] = __uint_as_float(w[e] << 16); f[2 * e + 1] = __uint_as_float(w[e] & 0xffff0000u); }
}
DI float quad_sum(float v) { v += dpp_f<0xB1>(v); v += dpp_f<0x4E>(v); return v; }
DI void rwkv_prep_phase(const P& p) {
    const int tid_ = TID(), lane = tid_ & 63, gw = blockIdx.x * 8 + (tid_ >> 6), NGW = gridDim.x * 8;
    const bf16_t* RKV = (const bf16_t*)(WSP(p, R_RKV)); const bf16_t* WAG = (const bf16_t*)(WSP(p, R_WAG));
    f32x4* SC = (f32x4*)(WSP(p, R_LORAH));
    const float* kkp = INP(p, 25) + 16 * lane; const float* kap = INP(p, 26) + 16 * lane; const float* rkp = INP(p, 27) + 16 * lane;
    for (int m = gw; m < MTOK; m += NGW) {
        const int t = m & 8191; const size_t idx = (size_t)m * DM + 16 * lane; const size_t idn = (size_t)(t < SEQ - 1 ? m + 1 : m) * DM + 16 * lane;
        float r[16], k[16], kn[16], a[16];
        { const u32x4* q; q = (const u32x4*)(RKV + idx); const u32x4 r0 = q[0], r1 = q[1]; q = (const u32x4*)(RKV + (size_t)MTOK * DM + idx); const u32x4 k0 = q[0], k1 = q[1];
          q = (const u32x4*)(RKV + (size_t)MTOK * DM + idn); const u32x4 n0 = q[0], n1 = q[1]; q = (const u32x4*)(WAG + (size_t)MTOK * DM + idx); const u32x4 a0 = q[0], a1 = q[1];
          unpack8(r0, r); unpack8(r1, r + 8); unpack8(k0, k); unpack8(k1, k + 8); unpack8(n0, kn); unpack8(n1, kn + 8); unpack8(a0, a); unpack8(a1, a + 8); }
        float s0 = 0.f, s1 = 0.f;
#pragma unroll
        for (int e = 0; e < 16; ++e) { const float x0 = k[e] * kkp[e], x1 = kn[e] * kkp[e]; s0 += x0 * x0; s1 += x1 * x1; }
        const float rs0 = rsqrtf(fmaxf(quad_sum(s0), 1e-24f)), rs1 = rsqrtf(fmaxf(quad_sum(s1), 1e-24f));
        float c1 = 0.f, c2 = 0.f, bn = 0.f;
#pragma unroll
        for (int e = 0; e < 16; ++e) { const float kk = k[e] * kkp[e] * rs0, kx = kn[e] * kkp[e] * rs1, kp = k[e] * (1.f + (a[e] - 1.f) * kap[e]);
            c1 += kk * a[e] * kx; c2 += kp * kx; bn += r[e] * kp * rkp[e]; }
        c1 = quad_sum(c1); c2 = quad_sum(c2); bn = quad_sum(bn);
        if ((lane & 3) == 0) SC[(size_t)m * 16 + (lane >> 2)] = (f32x4){rs0, c1, c2, bn};
    }
}
DI float wave_sum_fast(float v) {
    v = allreduce16(v);
    const int vi = __float_as_int(v);
    const float r0 = __int_as_float(__builtin_amdgcn_readlane(vi, 0)), r1 = __int_as_float(__builtin_amdgcn_readlane(vi, 16)), r2 = __int_as_float(__builtin_amdgcn_readlane(vi, 32)), r3 = __int_as_float(__builtin_amdgcn_readlane(vi, 48));
    return (r0 + r1) + (r2 + r3);
}
#define SCAN_BAR() do { asm volatile("s_waitcnt lgkmcnt(0)" ::: "memory"); __builtin_amdgcn_s_barrier(); asm volatile("" ::: "memory"); } while (0)
DI float allreduce8(float v) { v += dpp_f<0xB1>(v); v += dpp_f<0x4E>(v); v += dpp_f<0x141>(v); return v; }
constexpr int SC_CH = 16;
constexpr int SC_BUF_F = 5 * SC_CH * 64 + SC_CH * 64 + 2 * SC_CH;
constexpr int SC_Y_F = SC_CH * 8 * 8;
constexpr int SC_OFF_Y = 4 * SC_BUF_F, SC_OFF_KK0 = SC_OFF_Y + 6 * SC_Y_F, SC_OFF_TAB = SC_OFF_KK0 + 64;
static_assert((SC_OFF_TAB + 16) * 4 <= 143360 - 16 - 256, "scan LDS");
DI void scan_phase(const P& p, LAS unsigned char* lds) {
    const int tid = TID(), lane = tid & 63, wv = __builtin_amdgcn_readfirstlane(tid >> 6);
    const int chain = blockIdx.x >> 3, r8 = blockIdx.x & 7, b = chain >> 4, h = chain & 15;
    LAS float* fl = (LAS float*)lds;
    int role = 0, ridx = 0;
    {
        LAS int* simdtab = (LAS int*)(fl + SC_OFF_TAB);
        if (lane == 0) simdtab[wv] = (int)(__builtin_amdgcn_s_getreg((1 << 11) | (4 << 6) | 4) & 3u);
        __syncthreads();
        int sid[8], rl[8];
#pragma unroll
        for (int i = 0; i < 8; ++i) { sid[i] = __builtin_amdgcn_readfirstlane(simdtab[i]); rl[i] = 2; }
        unsigned used = 0u; int ncmp = 0;
#pragma unroll
        for (int i = 0; i < 8; ++i) if (ncmp < 3 && !((used >> sid[i]) & 1u)) { rl[i] = 0; used |= 1u << sid[i]; ++ncmp; }
#pragma unroll
        for (int i = 0; i < 8; ++i) if (ncmp < 3 && rl[i] == 2) { rl[i] = 0; ++ncmp; }
        int nwr = 0;
#pragma unroll
        for (int i = 7; i >= 0; --i) if (nwr < 1 && rl[i] == 2 && ((used >> sid[i]) & 1u)) { rl[i] = 1; ++nwr; }
#pragma unroll
        for (int i = 7; i >= 0; --i) if (nwr < 1 && rl[i] == 2) { rl[i] = 1; ++nwr; }
        int cnt0 = 0, cnt1 = 0, cnt2 = 0;
#pragma unroll
        for (int i = 0; i < 8; ++i) { if (i == wv) { role = rl[i]; ridx = rl[i] == 0 ? cnt0 : (rl[i] == 1 ? cnt1 : cnt2); } cnt0 += rl[i] == 0; cnt1 += rl[i] == 1; cnt2 += rl[i] == 2; }
    }
    if (role == 2) {
        const int sg = ridx >> 1, sw = ridx & 1;
        const bf16_t* RKV = (const bf16_t*)(WSP(p, R_RKV)); const bf16_t* WAG = (const bf16_t*)(WSP(p, R_WAG));
        const bf16_t* Rg = RKV; const bf16_t* Kg = RKV + (size_t)MTOK * DM; const bf16_t* Vg = RKV + (size_t)2 * MTOK * DM;
        const bf16_t* Eg = WAG; const bf16_t* Ag = WAG + (size_t)MTOK * DM;
        const float kkc = INP(p, 25)[h * 64 + lane], kac = INP(p, 26)[h * 64 + lane];
        const f32x4* SC = (const f32x4*)(WSP(p, R_LORAH)) + h;
        bf16_t rr[8], kr[9], vr[8], er[8], ar[8]; f32x4 sc[9];
        auto load_chunk = [&](int c) {
            const int t0 = sg * 4096 + c * SC_CH + sw * 8;
#pragma unroll
            for (int s8 = 0; s8 < 8; ++s8) { const size_t tok = (size_t)(b * SEQ + t0 + s8); const size_t idx = tok * DM + h * 64 + lane;
                rr[s8] = Rg[idx]; kr[s8] = Kg[idx]; vr[s8] = Vg[idx]; er[s8] = Eg[idx]; ar[s8] = Ag[idx]; sc[s8] = SC[tok * 16]; }
            { const size_t tok = (size_t)(b * SEQ + min(t0 + 8, SEQ - 1)); kr[8] = Kg[tok * DM + h * 64 + lane]; sc[8] = SC[tok * 16]; }
        };
        auto store_chunk = [&](int bufi, bool first) {
            LAS float* bp = fl + (sg * 2 + bufi) * SC_BUF_F;
#pragma unroll
            for (int s8 = 0; s8 < 8; ++s8) { const int st = sw * 8 + s8;
                const float kf = bf2f(kr[s8]), af = bf2f(ar[s8]);
                const float w = __expf(-bf2f(er[s8])); const float kp = kf * (1.f + (af - 1.f) * kac); const float kk = kf * kkc * sc[s8][0]; const float kn = bf2f(kr[s8 + 1]) * kkc * sc[s8 + 1][0];
                if (first && sw == 0 && s8 == 0) fl[SC_OFF_KK0 + lane] = kk;
                bp[0 * SC_CH * 64 + st * 64 + lane] = w * kn; bp[1 * SC_CH * 64 + st * 64 + lane] = w; bp[2 * SC_CH * 64 + st * 64 + lane] = kk * af;
                bp[3 * SC_CH * 64 + st * 64 + lane] = kp; bp[4 * SC_CH * 64 + st * 64 + lane] = bf2f(rr[s8]); bp[5 * SC_CH * 64 + st * 64 + lane] = bf2f(vr[s8]);
                if (lane == 0) { bp[6 * SC_CH * 64 + st * 2] = sc[s8][1]; bp[6 * SC_CH * 64 + st * 2 + 1] = sc[s8][2]; } }
        };
        load_chunk(0); store_chunk(0, sg == 1); load_chunk(1);
        SCAN_BAR();
        for (int c = 0; c < 256; ++c) {
            if (c + 1 < 256) store_chunk((c + 1) & 1, false);
            if (c + 2 < 256) load_chunk(c + 2);
            SCAN_BAR();
        }
    } else if (role == 1) {
        const int idx = lane * 2, st = idx >> 3, rl = idx & 7;
        bf16_t* Y = (bf16_t*)(WSP(p, R_Y)); float* YM = (float*)(WSP(p, WS_HB));
        bf16_t* yA = Y + ((size_t)(b * SEQ + st)) * DM + h * 64 + r8 * 8 + rl; bf16_t* yC = yA + (size_t)4096 * DM;
        float* yM = YM + ((size_t)(b * 4096 + st)) * DM + h * 64 + r8 * 8 + rl;
        auto ysum = [&](const LAS float* yb, float& o0, float& o1) {
            const LAS f32x4* q = (const LAS f32x4*)(yb + idx * 8);
            const f32x4 a0 = q[0], a1 = q[1], b0 = q[2], b1 = q[3];
            const f32x4 sa_ = a0 + a1, sb_ = b0 + b1;
            o0 = (sa_[0] + sa_[1]) + (sa_[2] + sa_[3]); o1 = (sb_[0] + sb_[1]) + (sb_[2] + sb_[3]);
        };
        auto flush = [&](int c) {
            const LAS float* yb = fl + SC_OFF_Y + (c & 1) * SC_Y_F; float o0, o1; const size_t off = (size_t)c * SC_CH * DM;
            ysum(yb, o0, o1); *(unsigned*)(yA + off) = cvtpk(o0, o1);
            ysum(yb + 2 * SC_Y_F, o0, o1); *(unsigned*)(yC + off) = cvtpk(o0, o1);
            ysum(yb + 4 * SC_Y_F, o0, o1); *(f32x2*)(yM + off) = (f32x2){o0, o1};
        };
        SCAN_BAR();
        for (int c = 0; c < 256; ++c) {
            if (c > 0) flush(c - 1);
            SCAN_BAR();
        }
        flush(255);
    } else {
        const int set = ridx, sg = set == 0 ? 0 : 1, ri = lane >> 3, cq = lane & 7, row = r8 * 8 + ri;
        f32x2 s0 = {0.f, 0.f}, s1 = s0, s2 = s0, s3 = s0;
        if (set == 2) { const int d = row - 8 * cq; s0[0] = d == 0 ? 1.f : 0.f; s0[1] = d == 1 ? 1.f : 0.f; s1[0] = d == 2 ? 1.f : 0.f; s1[1] = d == 3 ? 1.f : 0.f;
                        s2[0] = d == 4 ? 1.f : 0.f; s2[1] = d == 5 ? 1.f : 0.f; s3[0] = d == 6 ? 1.f : 0.f; s3[1] = d == 7 ? 1.f : 0.f; }
        const float vmul = set == 2 ? 0.f : 1.f;
        __builtin_amdgcn_s_setprio(2);
        SCAN_BAR();
        float sa = set == 2 ? -fl[SC_OFF_KK0 + row] : 0.f;
        for (int c = 0; c < 256; ++c) {
            const LAS float* bp = fl + (sg * 2 + (c & 1)) * SC_BUF_F + 8 * cq; const LAS float* vp = fl + (sg * 2 + (c & 1)) * SC_BUF_F + 5 * SC_CH * 64 + row;
            const LAS float* cp = fl + (sg * 2 + (c & 1)) * SC_BUF_F + 6 * SC_CH * 64;
            LAS float* yb = fl + SC_OFF_Y + (set * 2 + (c & 1)) * SC_Y_F + ri * 8 + cq;
            struct StepV { f32x4 qa, qb, wa, wb, ba, bb, pa, pb, ra, rb; float vv; f32x2 cc; };
            auto ldstep = [&](int st_) -> StepV {
                StepV v_;
                v_.qa = *(const LAS f32x4*)(bp + 0 * SC_CH * 64 + st_ * 64); v_.qb = *(const LAS f32x4*)(bp + 0 * SC_CH * 64 + st_ * 64 + 4);
                v_.wa = *(const LAS f32x4*)(bp + 1 * SC_CH * 64 + st_ * 64); v_.wb = *(const LAS f32x4*)(bp + 1 * SC_CH * 64 + st_ * 64 + 4);
                v_.ba = *(const LAS f32x4*)(bp + 2 * SC_CH * 64 + st_ * 64); v_.bb = *(const LAS f32x4*)(bp + 2 * SC_CH * 64 + st_ * 64 + 4);
                v_.pa = *(const LAS f32x4*)(bp + 3 * SC_CH * 64 + st_ * 64); v_.pb = *(const LAS f32x4*)(bp + 3 * SC_CH * 64 + st_ * 64 + 4);
                v_.ra = *(const LAS f32x4*)(bp + 4 * SC_CH * 64 + st_ * 64); v_.rb = *(const LAS f32x4*)(bp + 4 * SC_CH * 64 + st_ * 64 + 4);
                v_.vv = vp[st_ * 64] * vmul; v_.cc = *(const LAS f32x2*)(cp + st_ * 2);
                return v_;
            };
            StepV c0 = ldstep(0), c1 = ldstep(1);
#pragma unroll
            for (int st = 0; st < SC_CH; ++st) {
                const StepV c2 = ldstep(st + 2 < SC_CH ? st + 2 : SC_CH - 1);
                __builtin_amdgcn_sched_barrier(0x7);
                const f32x4 qa = c0.qa, qb = c0.qb, wa = c0.wa, wb = c0.wb, ba = c0.ba, bb = c0.bb, pa = c0.pa, pb = c0.pb, ra = c0.ra, rb = c0.rb; const float vv = c0.vv; const f32x2 cc = c0.cc;
                f32x2 t = s0 * (f32x2){qa[0], qa[1]}; t = s1 * (f32x2){qa[2], qa[3]} + t;
                f32x2 t2 = s2 * (f32x2){qb[0], qb[1]}; t2 = s3 * (f32x2){qb[2], qb[3]} + t2; t = t + t2;
                const float Rp = t[0] + t[1];
                const f32x2 vk = {vv, vv}; const f32x2 sa2 = {sa, sa};
                s0 = s0 * (f32x2){wa[0], wa[1]} + (sa2 * (f32x2){ba[0], ba[1]} + vk * (f32x2){pa[0], pa[1]});
                s1 = s1 * (f32x2){wa[2], wa[3]} + (sa2 * (f32x2){ba[2], ba[3]} + vk * (f32x2){pa[2], pa[3]});
                s2 = s2 * (f32x2){wb[0], wb[1]} + (sa2 * (f32x2){bb[0], bb[1]} + vk * (f32x2){pb[0], pb[1]});
                s3 = s3 * (f32x2){wb[2], wb[3]} + (sa2 * (f32x2){bb[2], bb[3]} + vk * (f32x2){pb[2], pb[3]});
                f32x2 u = s0 * (f32x2){ra[0], ra[1]}; u = s1 * (f32x2){ra[2], ra[3]} + u;
                f32x2 u2 = s2 * (f32x2){rb[0], rb[1]}; u2 = s3 * (f32x2){rb[2], rb[3]} + u2; u = u + u2;
                yb[st * 64] = u[0] + u[1];
                const float R = allreduce8(Rp);
                sa = -(R + (sa * cc[0] + vv * cc[1]));
                c0 = c1; c1 = c2;
            }
            SCAN_BAR();
        }
        __builtin_amdgcn_s_setprio(0);
        if (set == 0) {
            float* SF = (float*)(WSP(p, R_LORAH + 4 * MiB)) + ((size_t)chain * 64 + row) * 64 + 8 * cq;
            *(f32x4*)SF = (f32x4){s0[0], s0[1], s1[0], s1[1]}; *(f32x4*)(SF + 4) = (f32x4){s2[0], s2[1], s3[0], s3[1]};
        }
    }
}
DI void scan_fixup_phase(const P& p, LAS unsigned char* lds) {
    const int tid = TID(), i = tid & 63, tq = tid >> 6;
    const int chain = blockIdx.x >> 3, slice = blockIdx.x & 7, b = chain >> 4, h = chain & 15;
    LAS float* S = (LAS float*)lds;
    const float* SF = (const float*)(WSP(p, R_LORAH + 4 * MiB)) + (size_t)chain * 4096;
    for (int e = tid; e < 4096; e += 512) S[(e >> 6) * 65 + (e & 63)] = SF[e];
    __syncthreads();
    bf16_t* Y = (bf16_t*)(WSP(p, R_Y)); const float* YM = (const float*)(WSP(p, WS_HB));
    f32x4 cur[16], nxt[16]; bf16_t ycur, ynxt;
    auto issue = [&](int g, f32x4 (&dst)[16], bf16_t& yv) {
        const int tl = slice * 512 + g * 8 + tq;
        const f32x4* ym = (const f32x4*)(YM + ((size_t)(b * 4096 + tl)) * DM + h * 64);
#pragma unroll
        for (int q4 = 0; q4 < 16; ++q4) dst[q4] = ym[q4];
        yv = Y[((size_t)(b * SEQ + 4096 + tl)) * DM + h * 64 + i];
    };
    issue(0, cur, ycur);
    for (int g = 0; g < 64; ++g) {
        if (g + 1 < 64) issue(g + 1, nxt, ynxt);
        float acc = 0.f;
#pragma unroll
        for (int q4 = 0; q4 < 16; ++q4) { const f32x4 m4 = cur[q4]; const LAS float* sr = S + i * 65 + 4 * q4; acc += (sr[0] * m4[0] + sr[1] * m4[1]) + (sr[2] * m4[2] + sr[3] * m4[3]); }
        const int tl = slice * 512 + g * 8 + tq;
        Y[((size_t)(b * SEQ + 4096 + tl)) * DM + h * 64 + i] = f2bf(bf2f(ycur) + acc);
#pragma unroll
        for (int q4 = 0; q4 < 16; ++q4) cur[q4] = nxt[q4];
        ycur = ynxt;
    }
}
DI void rwkv_gn_phase(const P& p) {
    const int tid_ = TID(), lane = tid_ & 63, gw = blockIdx.x * 8 + (tid_ >> 6), NGW = gridDim.x * 8;
    const bf16_t* RKV = (const bf16_t*)(WSP(p, R_RKV)); const bf16_t* WAG = (const bf16_t*)(WSP(p, R_WAG)); const bf16_t* Y = (const bf16_t*)(WSP(p, R_Y));
    const f32x4* SC = (const f32x4*)(WSP(p, R_LORAH));
    bf16_t* HB = (bf16_t*)(WSP(p, WS_HB));
    const float* lnw = INP(p, 28) + 16 * lane; const float* lnb = INP(p, 29) + 16 * lane;
    for (int m = gw; m < MTOK; m += NGW) {
        const int b = m >> 13; const size_t idx = (size_t)m * DM + 16 * lane;
        float y[16], v[16], g[16];
        { const u32x4* q; q = (const u32x4*)(Y + idx); const u32x4 y0 = q[0], y1 = q[1];
          q = (const u32x4*)(RKV + (size_t)2 * MTOK * DM + idx); const u32x4 v0 = q[0], v1 = q[1];
          q = (const u32x4*)(WAG + (size_t)2 * MTOK * DM + idx); const u32x4 g0 = q[0], g1 = q[1];
          unpack8(y0, y); unpack8(y1, y + 8); unpack8(v0, v); unpack8(v1, v + 8); unpack8(g0, g); unpack8(g1, g + 8); }
        const float bn = SC[(size_t)m * 16 + (lane >> 2)][3];
        float s = 0.f;
#pragma unroll
        for (int e = 0; e < 16; ++e) s += y[e];
        const float mean = quad_sum(s) * (1.f / 64.f);
        float q2 = 0.f;
#pragma unroll
        for (int e = 0; e < 16; ++e) { y[e] -= mean; q2 += y[e] * y[e]; }
        const float rstd = rsqrtf(quad_sum(q2) * (1.f / 64.f) + 64e-5f);
        u32x4 o0, o1;
#pragma unroll
        for (int e = 0; e < 4; ++e) {
            const float f0 = (y[2 * e] * rstd * lnw[2 * e] + lnb[2 * e] + bn * v[2 * e]) * g[2 * e], f1 = (y[2 * e + 1] * rstd * lnw[2 * e + 1] + lnb[2 * e + 1] + bn * v[2 * e + 1]) * g[2 * e + 1];
            const float f2 = (y[8 + 2 * e] * rstd * lnw[8 + 2 * e] + lnb[8 + 2 * e] + bn * v[8 + 2 * e]) * g[8 + 2 * e], f3 = (y[9 + 2 * e] * rstd * lnw[9 + 2 * e] + lnb[9 + 2 * e] + bn * v[9 + 2 * e]) * g[9 + 2 * e];
            o0[e] = cvtpk(f0, f1); o1[e] = cvtpk(f2, f3); }
        u32x4* op = (u32x4*)(HB + (size_t)(m + 1 + b) * DM + 16 * lane); op[0] = o0; op[1] = o1;
    }
}
DI void pool_phase(const P& p) {
    const int tid_ = TID(), lane = tid_ & 63, gw = blockIdx.x * 8 + (tid_ >> 6), NGW = gridDim.x * 8;
    const bf16_t* HB = (const bf16_t*)(WSP(p, WS_HB)); bf16_t* PO = (bf16_t*)(WSP(p, R_POOLED));
    const int win = 2 << (lane >> 4);
    for (int m = gw; m < MTOK; m += NGW) {
        const int b = m >> 13, t = m & 8191; const bf16_t* hp = HB + (size_t)(m + 1 + b) * DM + 16 * lane;
        const int nwin = min(win, t + 1);
        u32x4 lo[16], hi8[16];
#pragma unroll
        for (int u = 0; u < 16; ++u) { const int uu = u < nwin ? u : 0; lo[u] = *(const u32x4*)(hp - (size_t)uu * DM); hi8[u] = *(const u32x4*)(hp - (size_t)uu * DM + 8); }
        float acc[16], self[16];
#pragma unroll
        for (int e = 0; e < 16; ++e) acc[e] = 0.f;
#pragma unroll
        for (int u = 0; u < 16; ++u) {
            const float msk = u < nwin ? 1.f : 0.f;
#pragma unroll
            for (int e = 0; e < 4; ++e) { const float f0 = __uint_as_float(lo[u][e] << 16), f1 = __uint_as_float(lo[u][e] & 0xffff0000u), f2 = __uint_as_float(hi8[u][e] << 16), f3 = __uint_as_float(hi8[u][e] & 0xffff0000u);
                acc[2 * e] += msk * f0; acc[2 * e + 1] += msk * f1; acc[8 + 2 * e] += msk * f2; acc[8 + 2 * e + 1] += msk * f3;
                if (u == 0) { self[2 * e] = f0; self[2 * e + 1] = f1; self[8 + 2 * e] = f2; self[8 + 2 * e + 1] = f3; } }
        }
        const float inv = 1.f / (float)nwin;
        u32x4 o0, o1;
#pragma unroll
        for (int e = 0; e < 4; ++e) { o0[e] = cvtpk(acc[2 * e] * inv - self[2 * e], acc[2 * e + 1] * inv - self[2 * e + 1]); o1[e] = cvtpk(acc[8 + 2 * e] * inv - self[8 + 2 * e], acc[8 + 2 * e + 1] * inv - self[8 + 2 * e + 1]); }
        *(u32x4*)(PO + (size_t)m * DM + 16 * lane) = o0; *(u32x4*)(PO + (size_t)m * DM + 16 * lane + 8) = o1;
    }
}


#define XB_TMO      128
#define XB_XCNT(j)  (256  + 64 * (j))
#define XB_XSUB(j)  (1280 + 64 * (j))
#define XB_XGEN(j)  (2304 + 64 * (j))
#define XB_TOP      3328
#define XB_TOPGEN   3392
#define XCD_BAR_WORDS 3456
#define XB_SPIN_CAP (1u << 22)
DI unsigned xb_ld(unsigned* p) { return __hip_atomic_load(p, __ATOMIC_RELAXED, __HIP_MEMORY_SCOPE_AGENT); }
DI unsigned xb_add(unsigned* p, unsigned v) { return __hip_atomic_fetch_add(p, v, __ATOMIC_RELAXED, __HIP_MEMORY_SCOPE_AGENT); }
DI unsigned xb_xcc_id() { return (unsigned)__builtin_amdgcn_s_getreg((3 << 11) | 20) & 0xFu; }
#define XB_SPIN(cond, bar) do { unsigned _sp = 0; while (cond) { __builtin_amdgcn_s_sleep(1); \
    if ((++_sp & 255u) == 0u) { if (xb_ld(&(bar)[XB_TMO])) break; if (_sp > XB_SPIN_CAP) { atomicAdd(&(bar)[XB_TMO], 1u); break; } } } } while (0)
struct XcdBarrier { unsigned* bar; unsigned x; volatile LAS unsigned* st; };
DI XcdBarrier xcd_barrier_post(unsigned* bar, volatile LAS unsigned* st) {
    XcdBarrier b; b.bar = bar; b.x = xb_xcc_id(); b.st = st;
    if (threadIdx.x == 0) (void)xb_add(&bar[XB_XCNT(b.x)], 1u);
    return b;
}
DI void xcd_barrier_complete(unsigned* bar, unsigned x, unsigned& nloc, unsigned& nx) {
    const unsigned G = gridDim.x * gridDim.y * gridDim.z;
    unsigned sum, cnt, mine, sp = 0u;
    for (;;) {
        sum = 0u; cnt = 0u; mine = 0u;
#pragma unroll
        for (unsigned j = 0; j < 16; ++j) { const unsigned c = xb_ld(&bar[XB_XCNT(j)]); sum += c; cnt += (c > 0u) ? 1u : 0u; mine = (j == x) ? c : mine; }
        if (sum == G) break;
        __builtin_amdgcn_s_sleep(1);
        if ((++sp & 255u) == 0u) { if (xb_ld(&bar[XB_TMO])) break; if (sp > XB_SPIN_CAP) { atomicAdd(&bar[XB_TMO], 1u); break; } }
    }
    nloc = mine > 0u ? mine : 1u; nx = cnt > 0u ? cnt : 1u;
}
DI void xcd_barrier(const P& p, LAS unsigned char* lds) {
    XcdBarrier b; b.bar = (unsigned*)WSP(p, WS_BAR); b.x = xb_xcc_id(); b.st = (volatile LAS unsigned*)(lds + LDS_BYTES - 16);
    asm volatile("s_waitcnt vmcnt(0)" ::: "memory");
    __syncthreads();
    if (TID() == 0) {
        unsigned* bar = b.bar;
        __builtin_amdgcn_s_waitcnt(0);
        unsigned nloc = b.st[0], nx = b.st[1];
        if (nloc == 0u) { xcd_barrier_complete(bar, b.x, nloc, nx); b.st[0] = nloc; b.st[1] = nx; }
        const unsigned old = xb_add(&bar[XB_XSUB(b.x)], 1u);
        const unsigned gen = old / nloc;
        if (old + 1u == (gen + 1u) * nloc) {
            __builtin_amdgcn_fence(__ATOMIC_RELEASE, "agent");
            asm volatile("s_waitcnt vmcnt(0)" ::: "memory");
            const unsigned og = xb_add(&bar[XB_TOP], 1u);
            const unsigned tg = og / nx;
            if (og + 1u == (tg + 1u) * nx) xb_add(&bar[XB_TOPGEN], 1u);
            else XB_SPIN(xb_ld(&bar[XB_TOPGEN]) == tg, bar);
            __builtin_amdgcn_fence(__ATOMIC_ACQUIRE, "agent");
            xb_add(&bar[XB_XGEN(b.x)], 1u);
            asm volatile("s_waitcnt vmcnt(0)" ::: "memory");
        } else {
            XB_SPIN(xb_ld(&bar[XB_XGEN(b.x)]) == gen, bar);
            __builtin_amdgcn_fence(__ATOMIC_ACQUIRE, "agent");
            asm volatile("s_waitcnt vmcnt(0)" ::: "memory");
        }
    }
    __syncthreads();
}
__global__ void __launch_bounds__(512, 2) fwd_kernel(P p) {
    LAS unsigned char* lds = (LAS unsigned char*)lds_raw;
    if ((threadIdx.x & 63) == 0) ((volatile LAS int*)(lds + WAVEMAP_OFF))[hw_wave_key()] = (int)(threadIdx.x >> 6);
    cg::grid_group grid = cg::this_grid();
    volatile LAS unsigned* xst = (volatile LAS unsigned*)(lds + LDS_BYTES - 16);
    if (threadIdx.x < 4) xst[threadIdx.x] = 0u;
    __syncthreads();
    (void)xcd_barrier_post((unsigned*)(p.ws + WS_BAR), xst);
#define GSYNC() xcd_barrier(p, lds)
    const int G = gridDim.x, bx = blockIdx.x;
    float* x = p.out;
#define MOD ((const float*)(WSP(p, WS_MOD)))
#define HB ((bf16_t*)(WSP(p, WS_HB)))
#define HA ((const bf16_t*)(WSP(p, WS_HB + 2048)))
    pg8::StaticOrder S;

    if (PH & 1) p0_phase(p, lds);
    if (DUP & 16) { __syncthreads(); p0_phase(p, lds); }
    if (p.ws == nullptr) grid.sync();
    GSYNC();

    for (int layer = 0; layer < 4; ++layer) {
        const int kind = layer % 3, j = layer / 3;
        const float* mod = MOD + (size_t)layer * 2 * 6144;
        if (PH & 2) norm_phase(layer == 0 ? INP(p, 0) : x, nullptr, HB, INP(p, 4) + layer * DM, mod + 0, mod + 1024);
        GSYNC();
        if (kind == 0) {
            { pg8::Gemm g{HA, (const bf16_t*)(WSP(p, W_NSA_IN + j * SZ_NSA_IN)), MTOK, NSA_INP, 1024, 1024, 2048, 0}; S.init(MTOK, NSA_INP, G, bx);
              EpiNsaIn E{(bf16_t*)(WSP(p, R_Q)), (bf16_t*)(WSP(p, R_KCV)), (bf16_t*)(WSP(p, R_KS)), (bf16_t*)(WSP(p, R_VS)), (bf16_t*)(WSP(p, R_KW)), (bf16_t*)(WSP(p, R_VW)), (float*)(WSP(p, R_GATES)), INP(p, 13) + j * 256};
              for (int rep_ = 0; rep_ < ((DUP & 512) ? 2 : 1); ++rep_) { pg8::gemm_phase<EpiNsaIn>(lds, g, S, E); if (DUP & 512) GSYNC(); } }
            GSYNC();
            { pg8::Gemm g{(const bf16_t*)(WSP(p, R_KCV)), (const bf16_t*)(WSP(p, W_CMP1 + j * SZ_CMP1)), 8192, 2048, 256, 1024, 0, 512, 2048, 512}; S.init(8192, 2048, G, bx);
              EpiCmp E{(float*)(WSP(p, R_CMPH))};
              if (PH & 8) pg8::gemm_phase<EpiCmp>(lds, g, S, E); }
            GSYNC();
            if (PH & 16) cmp2_phase(p, j, lds);
            if (DUP & 256) cmp2_phase(p, j, lds);
            GSYNC();
            if (PH & 32) attn_phase(p, lds, j);
            if (DUP & 1) { GSYNC(); attn_phase(p, lds, j); }
            GSYNC();
        } else if (kind == 1) {
            { pg8::Gemm g{HB, (const bf16_t*)(WSP(p, W_RIN)), MTOK, 3328, 2048, 1024, 2048, 0}; S.init(MTOK, 3328, G, bx);
              EpiRwkvIn E{(bf16_t*)(WSP(p, R_RKV)), (bf16_t*)(WSP(p, R_LORAH))};
              for (int rep_ = 0; rep_ < ((DUP & 1024) ? 2 : 1); ++rep_) { pg8::gemm_phase<EpiRwkvIn>(lds, g, S, E); if (DUP & 1024) GSYNC(); } }
            GSYNC();
            { pg8::Gemm g{(const bf16_t*)(WSP(p, R_LORAH)), (const bf16_t*)(WSP(p, W_L2)), MTOK, 3072, 256, 256, 0, 0}; S.init(MTOK, 3072, G, bx);
              EpiLora2 E{(bf16_t*)(WSP(p, R_WAG)), INP(p, 17), INP(p, 20)};
              for (int rep_ = 0; rep_ < ((DUP & 2048) ? 2 : 1); ++rep_) { pg8::gemm_phase<EpiLora2>(lds, g, S, E); if (DUP & 2048) GSYNC(); } }
            GSYNC();
            rwkv_prep_phase(p);
            GSYNC();
            if (PH & 256) scan_phase(p, lds);
            if (DUP & 2) { GSYNC(); scan_phase(p, lds); }
            GSYNC();
            scan_fixup_phase(p, lds);
            GSYNC();
            if (PH & 512) rwkv_gn_phase(p);
            if (DUP & 64) { rwkv_gn_phase(p); rwkv_prep_phase(p); }
            GSYNC();
        } else {
            if (PH & 1024) pool_phase(p);
            if (DUP & 128) pool_phase(p);
            GSYNC();
        }
        {
            pg8::Gemm g; EpiRes E{x, mod + 2048, nullptr, nullptr, layer == 0 ? INP(p, 0) : x};
            if (kind == 0) g = pg8::Gemm{(const bf16_t*)(WSP(p, R_O)), (const bf16_t*)(WSP(p, W_NSA_OUT + j * SZ_SQ)), MTOK, 1024, 1024, 1024, 0, 0};
            else if (kind == 1) g = pg8::Gemm{HA, (const bf16_t*)(WSP(p, W_ROUT)), MTOK, 1024, 1024, 1024, 2048, 0};
            else { g = pg8::Gemm{(const bf16_t*)(WSP(p, R_POOLED)), (const bf16_t*)(WSP(p, W_POOL)), MTOK, 1024, 256, 1024, 0, 512}; E.bias = INP(p, 32); E.pscale = INP(p, 33); }
            S.init(MTOK, 1024, G, bx);
            if (PH & 2048) pg8::gemm_phase<EpiRes>(lds, g, S, E);
        }
        GSYNC();
        if (PH & 2) norm_phase(x, nullptr, HB, INP(p, 5) + layer * DM, mod + 3072, mod + 4096);
        if (DUP & 32) { norm_phase(x, nullptr, HB, INP(p, 5) + layer * DM, mod + 3072, mod + 4096); norm_phase(x, nullptr, HB, INP(p, 5) + layer * DM, mod + 3072, mod + 4096); }
        GSYNC();
        { pg8::Gemm g{HA, (const bf16_t*)(WSP(p, W_GU + layer * SZ_GU)), MTOK, 2 * FF, 1024, 1024, 2048, 0}; S.init(MTOK, 2 * FF, G, bx);
          EpiFfnUp E{(bf16_t*)(WSP(p, R_ACT))};
          if (PH & 4096) pg8::gemm_phase<EpiFfnUp>(lds, g, S, E);
          if (DUP & 4) { GSYNC(); pg8::gemm_phase<EpiFfnUp>(lds, g, S, E); } }
        GSYNC();
        { pg8::Gemm g{(const bf16_t*)(WSP(p, R_ACT)), (const bf16_t*)(WSP(p, W_DN + layer * SZ_DN)), MTOK, 1024, FF, FF, 0, 0}; S.init(MTOK, 1024, G, bx);
          EpiRes E{x, mod + 5120, nullptr, nullptr, x};
          if (PH & 8192) pg8::gemm_phase<EpiRes>(lds, g, S, E); }
        if (layer < 3) GSYNC();
        if (DUP & 8) { for (int r_ = 0; r_ < 8; ++r_) GSYNC(); }
    }
}

extern "C" void kernel_launch(void* const* d_in, const int* in_sizes, int n_in, void* d_out, int out_size, void* d_ws, size_t ws_size, hipStream_t stream) {
    static int grid = 0;
    if (grid == 0) {
        if (n_in != 34 || ws_size < WS_END) { fprintf(stderr, "kernel_launch: unexpected n_in %d or ws_size %zu (need %zu)\n", n_in, ws_size, (size_t)WS_END); grid = -1; return; }
        int dev = 0, cus = 0, per_cu = 0;
        hipGetDevice(&dev); hipDeviceGetAttribute(&cus, hipDeviceAttributeMultiprocessorCount, dev);
        hipFuncSetAttribute((const void*)fwd_kernel, hipFuncAttributeMaxDynamicSharedMemorySize, LDS_BYTES);
        hipOccupancyMaxActiveBlocksPerMultiprocessor(&per_cu, (const void*)fwd_kernel, 512, LDS_BYTES);
        if (per_cu < 1) { fprintf(stderr, "kernel_launch: occupancy query says %d blocks per CU\n", per_cu); per_cu = 1; }
        grid = cus;
    }
    if (grid < 0) return;
    P p{};
    for (int i = 0; i < 34; ++i) p.in[i] = (const float*)d_in[i];
    p.out = (float*)d_out; p.ws = (unsigned char*)d_ws;
    (void)hipMemsetAsync((char*)d_ws + WS_BAR, 0, 16384, stream);
    void* args[] = {&p};
    hipError_t e = hipLaunchCooperativeKernel((const void*)fwd_kernel, dim3(grid), dim3(512), args, LDS_BYTES, stream);
    if (e != hipSuccess) fprintf(stderr, "cooperative launch failed: %s (grid %d)\n", hipGetErrorString(e), grid);
}
```

```cpp
#include <hip/hip_runtime.h>
#include <hip/hip_cooperative_groups.h>
#include <cstdio>
#include <cstdint>
namespace cg = cooperative_groups;

#define DI __device__ __forceinline__
#define LAS __attribute__((address_space(3)))
typedef unsigned short bf16_t;
typedef short bf16x8 __attribute__((ext_vector_type(8)));
typedef float f32x2 __attribute__((ext_vector_type(2)));
typedef float f32x4 __attribute__((ext_vector_type(4)));
typedef float f32x16 __attribute__((ext_vector_type(16)));
typedef unsigned u32x2 __attribute__((ext_vector_type(2)));
typedef unsigned u32x4 __attribute__((ext_vector_type(4)));
typedef __bf16 bf16x2_t __attribute__((ext_vector_type(2)));

constexpr int SEQ = 8192, DM = 1024, MTOK = 16384, FF = 2816;
constexpr int NSA_IN = 2608, NSA_INP = 2816;
constexpr float LOG2E = 1.4426950408889634f;
constexpr float QSCALE = 0.125f * LOG2E;
constexpr float RMS_EPS = 1e-6f;

constexpr size_t MiB = 1u << 20;
constexpr size_t WS_MOD = 0;
constexpr size_t WS_PBIAS = 256 * 1024;
constexpr size_t WS_BAR = 512 * 1024;
constexpr size_t WS_W = 1 * MiB;
constexpr size_t SZ_NSA_IN = (size_t)NSA_INP * 1024 * 2, SZ_SQ = (size_t)1024 * 1024 * 2, SZ_CMP1 = (size_t)256 * 2048 * 2;
constexpr size_t SZ_GU = (size_t)2 * FF * 1024 * 2, SZ_DN = (size_t)1024 * FF * 2, SZ_RIN = (size_t)3328 * 2048 * 2, SZ_L2 = (size_t)3072 * 256 * 2, SZ_POOL = (size_t)1024 * 256 * 2;
constexpr size_t W_NSA_IN = WS_W, W_NSA_OUT = W_NSA_IN + 2 * SZ_NSA_IN, W_CMP1 = W_NSA_OUT + 2 * SZ_SQ, W_GU = W_CMP1 + 2 * SZ_CMP1, W_DN = W_GU + 4 * SZ_GU,
                 W_RIN = W_DN + 4 * SZ_DN, W_L2 = W_RIN + SZ_RIN, W_ROUT = W_L2 + SZ_L2, W_POOL = W_ROUT + SZ_SQ, W_END = W_POOL + SZ_POOL;
static_assert(W_END == 101 * MiB, "weights");
constexpr size_t WS_HB = 101 * MiB;
constexpr size_t WS_R = 136 * MiB;
constexpr size_t R_Q = WS_R, R_KCV = WS_R + 32 * MiB, R_KS = WS_R + 50 * MiB, R_VS = WS_R + 58 * MiB, R_KW = WS_R + 66 * MiB, R_VW = WS_R + 74 * MiB,
                 R_GATES = WS_R + 82 * MiB, R_CMPH = WS_R + 128 * MiB  , R_KCMP = WS_R + 90 * MiB, R_VCMP = WS_R + 91 * MiB, R_O = WS_R + 92 * MiB;
constexpr size_t R_ACT = WS_R;
constexpr size_t R_RKV = WS_R, R_LORAH = WS_R + 96 * MiB, R_WAG = WS_R + 104 * MiB, R_Y = WS_R + 200 * MiB;
constexpr size_t R_POOLED = WS_R;
constexpr size_t WS_END = WS_R + 232 * MiB;

constexpr int LDS_BYTES = 143360;

#ifndef PH
#define PH 0xFFFF
#endif
#ifndef DUP
#define DUP 0
#endif
struct P { const float* in[34]; float* out; unsigned char* ws; };

extern __shared__ __attribute__((aligned(16))) unsigned char lds_raw[];
constexpr int WAVEMAP_OFF = 143360 - 16 - 256;
DI unsigned hw_wave_key() { return (unsigned)__builtin_amdgcn_s_getreg((5 << 11) | 4) & 63u; }
DI int TID() {
    const int w = __builtin_amdgcn_readfirstlane(((volatile LAS int*)((LAS unsigned char*)lds_raw + WAVEMAP_OFF))[hw_wave_key()]);
    unsigned z = 0u; asm volatile("" : "+v"(z));
    int t = w * 64 + (int)__builtin_amdgcn_mbcnt_hi(~0u, __builtin_amdgcn_mbcnt_lo(~0u, z));
    asm volatile("" : "+v"(t)); return t;
}
DI const float* INP(const P& p, int i) { asm volatile("" : "+s"(i)); return p.in[i]; }
DI unsigned char* WSP(const P& p, size_t off) { asm volatile("" : "+s"(off)); return p.ws + off; }
DI unsigned cvtpk(float lo, float hi) { f32x2 v = {lo, hi}; bf16x2_t b = __builtin_convertvector(v, bf16x2_t); return __builtin_bit_cast(unsigned, b); }
DI bf16_t f2bf(float f) { return (bf16_t)(cvtpk(f, 0.f) & 0xffffu); }
DI float bf2f(bf16_t u) { return __uint_as_float(((unsigned)u) << 16); }
DI float wave_sum(float v) {
#pragma unroll
    for (int o = 1; o < 64; o <<= 1) v += __shfl_xor(v, o);
    return v;
}
DI float sigmoidf_(float x) { return 1.f / (1.f + __expf(-x)); }
template <int CTRL> DI int dpp_i(int v) { return __builtin_amdgcn_update_dpp(0, v, CTRL, 0xf, 0xf, false); }
DI int crow(int r, int h) { return (r & 3) + 8 * (r >> 2) + 4 * h; }

namespace pg8 {
constexpr int BM = 256, BK = 64, HALF = 128, HTB = HALF * BK * 2, STAGE_BYTES = 8 * HTB, NXCD = 8, WGM = 8;
DI int lds_byte(int r, int c) { const int st = (r >> 4) * 2 + (c >> 5), rr = r & 15, cc = c & 31, ob = rr * 64 + cc * 2; return st * 1024 + (ob ^ (((ob >> 9) & 1) << 5)); }
DI void stage_rc(int b, int& R, int& C) { const int st = b / 1024, sb = b % 1024, swz = sb ^ (((sb >> 9) & 1) << 5); R = (st >> 1) * 16 + swz / 64; C = (st & 1) * 32 + (swz % 64) / 2; }
struct Unit { int pm, pn; };
struct Gemm { const bf16_t* A; const bf16_t* Bt; int M, N, K, lda; int a_extra; int a_pn; int ldb; int b_pn; };
struct StaticOrder {
    int nM, nN, nwg, G, c;
    DI void init(int M, int N, int G_, int c_) { nM = M / BM; nN = N / BM; nwg = nM * nN; G = G_; c = c_; }
    DI bool next(int i, Unit& u) const {
        const long L = (long)i * G + c; if (L >= nwg) return false;
        int wgid = (int)L; { const int q = nwg / NXCD, r = nwg % NXCD, xcd = wgid % NXCD, off = wgid / NXCD; wgid = (xcd < r ? xcd * (q + 1) : r * (q + 1) + (xcd - r) * q) + off; }
        const int nig = WGM * nN, gid = wgid / nig, fm = gid * WGM, gsz = (nM - fm) < WGM ? (nM - fm) : WGM;
        u.pm = fm + ((wgid % nig) % gsz); u.pn = (wgid % nig) / gsz; return true;
    }
};

template <class Epi>
DI void gemm_phase(LAS unsigned char* lds, const Gemm g, const StaticOrder& S, const Epi& E) {
    const int tid = TID(), wid = __builtin_amdgcn_readfirstlane(tid >> 6), lane = tid & 63, wr = wid >> 2, wc = wid & 3, fr = lane & 15, fq = lane >> 4;
    int K = g.K; asm volatile("" : "+s"(K)); const int nt = K / BK;
    unsigned voffA[2], voffB[2];
    const int ldb = g.ldb ? g.ldb : K;
#pragma unroll
    for (int i = 0; i < 2; ++i) { int R, C; stage_rc(tid * 16 + i * 8192, R, C); voffA[i] = (unsigned)(R * g.lda + C) * 2u; voffB[i] = (unsigned)(R * ldb + C) * 2u; }
    const size_t kstep = (size_t)(BK * 2);
    const size_t hstepA = (size_t)HALF * g.lda * 2, hstepB = (size_t)HALF * ldb * 2;
    const size_t tstepA = 2 * hstepA, tstepB = g.b_pn ? (size_t)g.b_pn : 2 * hstepB;
    const unsigned ldsw = (unsigned)wid * 1024u;
    const int aoff = lds_byte(wr * 64 + fr, fq * 8), boff = lds_byte(wc * 32 + fr, fq * 8);
#define PG8_SA(b, h) (((b) * 2 + (h)) * HTB)
#define PG8_SB(b, h) ((4 + (b) * 2 + (h)) * HTB)
#define PG8_STAGE(bufoff, gbase, voff) do { _Pragma("unroll") for (int _i = 0; _i < 2; ++_i) \
        __builtin_amdgcn_global_load_lds((const unsigned*)((const char*)(gbase) + (voff)[_i]), (LAS unsigned*)(lds + (bufoff) + ldsw + _i * 8192), 16, 0, 0); } while (0)
#define PG8_LDA(dst, b, h) do { _Pragma("unroll") for (int m = 0; m < 4; ++m) _Pragma("unroll") for (int k = 0; k < 2; ++k) dst[m][k] = *(const LAS bf16x8*)(lds + PG8_SA(b, h) + aoff + m * 2048 + k * 1024); } while (0)
#define PG8_LDB(dst, b, h) do { _Pragma("unroll") for (int n = 0; n < 2; ++n) _Pragma("unroll") for (int k = 0; k < 2; ++k) dst[n][k] = *(const LAS bf16x8*)(lds + PG8_SB(b, h) + boff + n * 2048 + k * 1024); } while (0)
#define PG8_MMA(ai, bj, At, Bt) do { __builtin_amdgcn_s_setprio(1); _Pragma("unroll") for (int m = 0; m < 4; ++m) _Pragma("unroll") for (int n = 0; n < 2; ++n) _Pragma("unroll") for (int k = 0; k < 2; ++k) \
        acc[ai][bj][m][n] = __builtin_amdgcn_mfma_f32_16x16x32_bf16(Bt[n][k], At[m][k], acc[ai][bj][m][n], 0, 0, 0); __builtin_amdgcn_s_setprio(0); } while (0)
#define PG8_WAIT_V(n) asm volatile("s_waitcnt vmcnt(" #n ")" ::: "memory")
#define PG8_WAIT_L(n) asm volatile("s_waitcnt lgkmcnt(" #n ")" ::: "memory")
#define PG8_BAR __builtin_amdgcn_s_barrier()
#define PG8_SCHED __builtin_amdgcn_sched_barrier(0)
#define PG8_AOF(u_) ((const char*)g.A + (size_t)(u_).pm * tstepA + (size_t)((u_).pm >> 5) * (size_t)g.a_extra + (size_t)(u_).pn * (size_t)g.a_pn)
    Unit cur, nxt; int ui = 0;
    if (!S.next(0, cur)) return;
    f32x4 acc[2][2][4][2];
#pragma unroll
    for (int a = 0; a < 2; ++a)
#pragma unroll
        for (int b = 0; b < 2; ++b)
#pragma unroll
            for (int m = 0; m < 4; ++m)
#pragma unroll
                for (int n = 0; n < 2; ++n) acc[a][b][m][n] = (f32x4){0.f, 0.f, 0.f, 0.f};
    bf16x8 At[4][2], B0[2][2], B1[2][2];
    const char* cA = PG8_AOF(cur); const char* cB = (const char*)g.Bt + (size_t)cur.pn * tstepB;
    PG8_STAGE(PG8_SB(0, 0), cB, voffB); PG8_STAGE(PG8_SB(0, 1), cB + hstepB, voffB); PG8_STAGE(PG8_SA(0, 0), cA, voffA); PG8_STAGE(PG8_SA(0, 1), cA + hstepA, voffA);
    if (wr == 1) PG8_BAR;
    PG8_WAIT_V(2); PG8_BAR;
    PG8_STAGE(PG8_SB(1, 0), cB + kstep, voffB); PG8_STAGE(PG8_SA(1, 0), cA + kstep, voffA); PG8_STAGE(PG8_SB(1, 1), cB + hstepB + kstep, voffB);
    PG8_WAIT_V(6); PG8_BAR;
    for (;;) {
        const bool has_next = S.next(ui + 1, nxt);
        const char* nA = has_next ? PG8_AOF(nxt) : cA; const char* nB = has_next ? (const char*)g.Bt + (size_t)nxt.pn * tstepB : cB;
        for (int t = 0; t < nt; t += 2) {
            const bool last = (t == nt - 2);
            const char* a1 = cA + (size_t)(t + 1) * kstep;
            const char* a2 = last ? nA : cA + (size_t)(t + 2) * kstep; const char* b2 = last ? nB : cB + (size_t)(t + 2) * kstep;
            const char* a3 = a2 + kstep; const char* b3 = b2 + kstep;
            PG8_LDB(B0, 0, 0); PG8_LDB(B1, 0, 1); PG8_SCHED; PG8_LDA(At, 0, 0); PG8_STAGE(PG8_SA(1, 1), a1 + hstepA, voffA);
            PG8_WAIT_V(8); PG8_WAIT_L(0); PG8_BAR; PG8_MMA(0, 0, At, B0); PG8_MMA(0, 1, At, B1); PG8_BAR; PG8_SCHED;
            PG8_LDA(At, 0, 1); PG8_STAGE(PG8_SB(0, 0), b2, voffB); PG8_STAGE(PG8_SB(0, 1), b2 + hstepB, voffB); PG8_STAGE(PG8_SA(0, 0), a2, voffA);
            PG8_WAIT_V(8); PG8_WAIT_L(0); PG8_BAR; PG8_MMA(1, 0, At, B0); PG8_MMA(1, 1, At, B1); PG8_BAR; PG8_SCHED;
            PG8_LDB(B0, 1, 0); PG8_LDB(B1, 1, 1); PG8_SCHED; PG8_LDA(At, 1, 0); PG8_STAGE(PG8_SA(0, 1), a2 + hstepA, voffA);
            PG8_WAIT_V(8); PG8_WAIT_L(0); PG8_BAR; PG8_MMA(0, 0, At, B0); PG8_MMA(0, 1, At, B1); PG8_BAR; PG8_SCHED;
            PG8_LDA(At, 1, 1); PG8_STAGE(PG8_SB(1, 0), b3, voffB); PG8_STAGE(PG8_SB(1, 1), b3 + hstepB, voffB); PG8_STAGE(PG8_SA(1, 0), a3, voffA);
            PG8_WAIT_V(8); PG8_WAIT_L(0); PG8_BAR; PG8_MMA(1, 0, At, B0); PG8_MMA(1, 1, At, B1); PG8_BAR; PG8_SCHED;
        }
        if (wr == 0) PG8_BAR;
        E(acc, cur, wr, wc, fr, fq);
        if (!has_next) break;
#pragma unroll
        for (int a = 0; a < 2; ++a)
#pragma unroll
            for (int b = 0; b < 2; ++b)
#pragma unroll
                for (int m = 0; m < 4; ++m)
#pragma unroll
                    for (int n = 0; n < 2; ++n) acc[a][b][m][n] = (f32x4){0.f, 0.f, 0.f, 0.f};
        cur = nxt; cA = nA; cB = nB; ++ui;
        if (wr == 1) PG8_BAR;
    }
    PG8_WAIT_V(0);
    PG8_BAR;
#undef PG8_SA
#undef PG8_SB
#undef PG8_STAGE
#undef PG8_LDA
#undef PG8_LDB
#undef PG8_MMA
#undef PG8_WAIT_V
#undef PG8_WAIT_L
#undef PG8_BAR
#undef PG8_SCHED
#undef PG8_AOF
}
}
using pg8::Unit;
typedef f32x4 AccT[2][2][4][2];

DI void st_bf4(bf16_t* p, f32x4 v) { u32x2 w; w.x = cvtpk(v[0], v[1]); w.y = cvtpk(v[2], v[3]); *(u32x2*)p = w; }

struct EpiRes {
    float* x; const float* gate; const float* bias; const float* pscale; const float* xin;
    DI void operator()(const AccT& acc, const Unit& u, int wr, int wc, int fr, int fq) const {
        const int b = u.pm >> 5; const float* gp = gate + b * 6144;
        const int colb = u.pn * 256 + wc * 64 + fq * 4;
        f32x4 g4[2][2], b4[2][2];
#pragma unroll
        for (int bj = 0; bj < 2; ++bj)
#pragma unroll
            for (int n = 0; n < 2; ++n) {
                const int col = colb + bj * 32 + n * 16;
                g4[bj][n] = *(const f32x4*)(gp + col);
                if (bias) { const f32x4 s4 = *(const f32x4*)(pscale + col); g4[bj][n] = g4[bj][n] * s4; b4[bj][n] = *(const f32x4*)(bias + col) * g4[bj][n]; }
                else b4[bj][n] = (f32x4){0.f, 0.f, 0.f, 0.f};
            }
#pragma unroll
        for (int ai = 0; ai < 2; ++ai)
#pragma unroll
            for (int mh = 0; mh < 2; ++mh) {
                f32x4 xv[2][2][2];
#pragma unroll
                for (int m2 = 0; m2 < 2; ++m2) { const float* xr = xin + (size_t)(u.pm * 256 + ai * 128 + wr * 64 + (mh * 2 + m2) * 16 + fr) * DM + colb;
#pragma unroll
                    for (int bj = 0; bj < 2; ++bj)
#pragma unroll
                        for (int n = 0; n < 2; ++n) xv[m2][bj][n] = *(const f32x4*)(xr + bj * 32 + n * 16); }
#pragma unroll
                for (int m2 = 0; m2 < 2; ++m2) { float* xr = x + (size_t)(u.pm * 256 + ai * 128 + wr * 64 + (mh * 2 + m2) * 16 + fr) * DM + colb;
#pragma unroll
                    for (int bj = 0; bj < 2; ++bj)
#pragma unroll
                        for (int n = 0; n < 2; ++n) *(f32x4*)(xr + bj * 32 + n * 16) = xv[m2][bj][n] + g4[bj][n] * acc[ai][bj][mh * 2 + m2][n] + b4[bj][n]; }
                asm volatile("" ::: "memory");
            }
    }
};
struct EpiFfnUp {
    bf16_t* act;
    DI void operator()(const AccT& acc, const Unit& u, int wr, int wc, int fr, int fq) const {
#pragma unroll
        for (int ai = 0; ai < 2; ++ai)
#pragma unroll
            for (int m = 0; m < 4; ++m) {
                const int row = u.pm * 256 + ai * 128 + wr * 64 + m * 16 + fr; bf16_t* ar = act + (size_t)row * FF;
#pragma unroll
                for (int bj = 0; bj < 2; ++bj) {
                    const f32x4 gt = acc[ai][bj][m][0], up = acc[ai][bj][m][1]; f32x4 o;
#pragma unroll
                    for (int j = 0; j < 4; ++j) o[j] = gt[j] * __builtin_amdgcn_rcpf(1.f + __builtin_amdgcn_exp2f(-gt[j] * LOG2E)) * up[j];
                    st_bf4(ar + 16 * (8 * u.pn + 2 * wc + bj) + 4 * fq, o);
                }
            }
    }
};
struct EpiNsaIn {
    bf16_t *Q, *KCV, *KS, *VS, *KW, *VW; float* GATES; const float* qkn;
    DI void operator()(const AccT& acc, const Unit& u, int wr, int wc, int fr, int fq) const {
        const int pn = u.pn, b = u.pm >> 5;
        if (pn >= 10) {
            if (pn > 10 || wc != 0) return;
#pragma unroll
            for (int ai = 0; ai < 2; ++ai)
#pragma unroll
                for (int m = 0; m < 4; ++m) {
                    const int row = u.pm * 256 + ai * 128 + wr * 64 + m * 16 + fr;
#pragma unroll
                    for (int bj = 0; bj < 2; ++bj)
#pragma unroll
                        for (int n = 0; n < 2; ++n) {
                            const int c = bj * 32 + n * 16 + fq * 4;
                            if (c < 48) { f32x4 v = acc[ai][bj][m][n]; f32x4 o;
#pragma unroll
                                for (int j = 0; j < 4; ++j) o[j] = sigmoidf_(v[j]);
                                *(f32x4*)(GATES + (size_t)row * 48 + c) = o; }
                        }
                }
            return;
        }
        const bool nrm = (pn < 4) || pn == 6 || pn == 8;
        const int nidx = pn < 4 ? 0 : (pn == 6 ? 2 : 3);
        const float osc = pn < 4 ? QSCALE : 1.f;
        bf16_t* base; size_t rs;
        if (pn < 4) { base = Q + (size_t)(b * SEQ) * DM + pn * 256 + wc * 64; rs = DM; }
        else { bf16_t* arr = pn == 4 ? KCV : pn == 5 ? KCV + (size_t)8 * 524288 : pn == 6 ? KS : pn == 7 ? VS : pn == 8 ? KW : VW; base = arr + (size_t)(b * 4 + wc) * 524288; rs = 64; }
        f32x4 qw[2][2];
#pragma unroll
        for (int bj = 0; bj < 2; ++bj)
#pragma unroll
            for (int n = 0; n < 2; ++n) qw[bj][n] = nrm ? *(const f32x4*)(qkn + nidx * 64 + bj * 32 + n * 16 + fq * 4) : (f32x4){1.f, 1.f, 1.f, 1.f};
#pragma unroll
        for (int ai = 0; ai < 2; ++ai)
#pragma unroll
            for (int m = 0; m < 4; ++m) {
                const int t = (u.pm & 31) * 256 + ai * 128 + wr * 64 + m * 16 + fr;
                float rstd = 1.f;
                if (nrm) {
                    float ss = 0.f;
#pragma unroll
                    for (int bj = 0; bj < 2; ++bj)
#pragma unroll
                        for (int n = 0; n < 2; ++n) { const f32x4 v = acc[ai][bj][m][n]; ss += (v[0] * v[0] + v[1] * v[1]) + (v[2] * v[2] + v[3] * v[3]); }
                    ss += __shfl_xor(ss, 16); ss += __shfl_xor(ss, 32);
                    rstd = rsqrtf(ss * (1.f / 64.f) + RMS_EPS) * osc;
                }
#pragma unroll
                for (int bj = 0; bj < 2; ++bj)
#pragma unroll
                    for (int n = 0; n < 2; ++n) {
                        const int d = bj * 32 + n * 16 + fq * 4; const f32x4 v = acc[ai][bj][m][n] * rstd * qw[bj][n];
                        st_bf4(base + (size_t)t * rs + d, v);
                    }
            }
    }
};
DI float gelu_tanh(float x) { const float u = 0.7978845608028654f * (x + 0.044715f * x * x * x); const float e = __expf(2.f * u); const float th = 1.f - 2.f / (e + 1.f); return 0.5f * x * (1.f + th); }
struct EpiCmp {
    float* PART;
    DI void operator()(const AccT& acc, const Unit& u, int wr, int wc, int fr, int fq) const {
        const int kv = u.pm >> 4;
        if ((wc >> 1) != kv) return;
        float* base = PART + (size_t)u.pn * 8192 * 128 + (wc & 1) * 64 + fq * 4;
#pragma unroll
        for (int ai = 0; ai < 2; ++ai)
#pragma unroll
            for (int m = 0; m < 4; ++m) {
                const int row = u.pm * 256 + ai * 128 + wr * 64 + m * 16 + fr;
#pragma unroll
                for (int bj = 0; bj < 2; ++bj)
#pragma unroll
                    for (int n = 0; n < 2; ++n) *(f32x4*)(base + (size_t)row * 128 + bj * 32 + n * 16) = acc[ai][bj][m][n];
            }
    }
};
struct EpiRwkvIn {
    bf16_t* RKV; bf16_t* LORAH;
    DI void operator()(const AccT& acc, const Unit& u, int wr, int wc, int fr, int fq) const {
        const int pn = u.pn;
        if (pn < 12) {
            bf16_t* base = RKV + (size_t)(pn >> 2) * MTOK * DM + (pn & 3) * 256 + wc * 64 + fq * 4;
#pragma unroll
            for (int ai = 0; ai < 2; ++ai)
#pragma unroll
                for (int m = 0; m < 4; ++m) {
                    const int row = u.pm * 256 + ai * 128 + wr * 64 + m * 16 + fr;
#pragma unroll
                    for (int bj = 0; bj < 2; ++bj)
#pragma unroll
                        for (int n = 0; n < 2; ++n) st_bf4(base + (size_t)row * DM + bj * 32 + n * 16, acc[ai][bj][m][n]);
                }
        } else {
            bf16_t* base = LORAH + wc * 64 + fq * 4;
#pragma unroll
            for (int ai = 0; ai < 2; ++ai)
#pragma unroll
                for (int m = 0; m < 4; ++m) {
                    const int row = u.pm * 256 + ai * 128 + wr * 64 + m * 16 + fr;
#pragma unroll
                    for (int bj = 0; bj < 2; ++bj)
#pragma unroll
                        for (int n = 0; n < 2; ++n) { const f32x4 v = acc[ai][bj][m][n]; f32x4 o;
#pragma unroll
                            for (int j = 0; j < 4; ++j) { const float z = v[j]; const float sg = __builtin_amdgcn_rcpf(1.f + __builtin_amdgcn_exp2f(-z * (wc == 0 ? 2.f * LOG2E : LOG2E))); o[j] = wc == 0 ? (2.f * sg - 1.f) : (wc == 1 ? z : sg); }
                            st_bf4(base + (size_t)row * 256 + bj * 32 + n * 16, o); }
                    asm volatile("" ::: "memory");
                }
        }
    }
};
struct EpiLora2 {
    bf16_t* WAG; const float* w0; const float* a0;
    DI void operator()(const AccT& acc, const Unit& u, int wr, int wc, int fr, int fq) const {
        const int pn = u.pn, which = pn >> 2;
        const int colb = (pn & 3) * 256 + wc * 64 + fq * 4;
        bf16_t* base = WAG + (size_t)which * MTOK * DM + colb;
        const float* addp = which == 0 ? w0 : a0;
        const float osc = which == 0 ? 0.6065306597126334f : 1.f;
        f32x4 ad[2][2];
#pragma unroll
        for (int bj = 0; bj < 2; ++bj)
#pragma unroll
            for (int n = 0; n < 2; ++n) ad[bj][n] = which < 2 ? *(const f32x4*)(addp + colb + bj * 32 + n * 16) : (f32x4){0.f, 0.f, 0.f, 0.f};
#pragma unroll
        for (int ai = 0; ai < 2; ++ai)
#pragma unroll
            for (int m = 0; m < 4; ++m) {
                const int row = u.pm * 256 + ai * 128 + wr * 64 + m * 16 + fr;
#pragma unroll
                for (int bj = 0; bj < 2; ++bj)
#pragma unroll
                    for (int n = 0; n < 2; ++n) {
                        f32x4 v = acc[ai][bj][m][n]; f32x4 o;
                        if (which < 2) { const f32x4 a4 = ad[bj][n];
#pragma unroll
                            for (int j = 0; j < 4; ++j) o[j] = osc * __builtin_amdgcn_rcpf(1.f + __builtin_amdgcn_exp2f(-(v[j] + a4[j]) * LOG2E)); }
                        else o = v;
                        st_bf4(base + (size_t)row * DM + bj * 32 + n * 16, o);
                    }
                asm volatile("" ::: "memory");
            }
    }
};

DI float wsrc(const P& p, int id, int k, int c) {
    if (id < 2) { const float* W = p.in[9] + (size_t)id * 1024 * NSA_IN; return c < NSA_IN ? W[(size_t)k * NSA_IN + c] : 0.f; }
    if (id < 4) { const float* W = p.in[14] + (size_t)(id - 2) * 1024 * 1024; return W[(size_t)k * 1024 + c]; }
    if (id < 6) { const int kv = c >> 7; const float* W = p.in[11] + (size_t)((id - 4) * 2 + kv) * 2048 * 128; return W[(size_t)k * 128 + (c & 127)]; }
    if (id < 10) { const int grp = c >> 5, w = c & 31, col = grp * 16 + (w & 15); const float* W = ((w >> 4) ? p.in[7] : p.in[6]) + (size_t)(id - 6) * 1024 * FF; return W[(size_t)k * FF + col]; }
    if (id < 14) { const float* W = p.in[8] + (size_t)(id - 10) * FF * 1024; return W[(size_t)k * 1024 + c]; }
    if (id == 14) {
        const int kk = k & 1023; const bool prev = k < 1024; int mi, ldw, cc; const float* W;
        if (c < 3072) { const int which = c >> 10; mi = which == 0 ? 0 : (which == 1 ? 2 : 3); W = p.in[16] + (size_t)which * 1024 * 1024; ldw = 1024; cc = c & 1023; }
        else if (c < 3136) { mi = 1; W = p.in[18]; ldw = 64; cc = c - 3072; }
        else if (c < 3200) { mi = 4; W = p.in[21]; ldw = 64; cc = c - 3136; }
        else { mi = 5; W = p.in[23]; ldw = 128; cc = c - 3200; }
        const float mu = p.in[15][mi * 1024 + kk], w = W[(size_t)kk * ldw + cc];
        return prev ? mu * w : (1.f - mu) * w;
    }
    if (id == 15) {
        if (c < 1024) return k < 64 ? p.in[19][(size_t)k * 1024 + c] : 0.f;
        if (c < 2048) return (k >= 64 && k < 128) ? p.in[22][(size_t)(k - 64) * 1024 + (c - 1024)] : 0.f;
        return k >= 128 ? p.in[24][(size_t)(k - 128) * 1024 + (c - 2048)] : 0.f;
    }
    if (id == 16) return p.in[30][(size_t)k * 1024 + c];
    return p.in[31][(size_t)((c >> 8) * 256 + k) * 256 + (c & 255)];
}
DI void mat_info(int id, int& N, int& K, size_t& off) {
    if (id < 2) { N = NSA_INP; K = 1024; off = W_NSA_IN + id * SZ_NSA_IN; }
    else if (id < 4) { N = 1024; K = 1024; off = W_NSA_OUT + (id - 2) * SZ_SQ; }
    else if (id < 6) { N = 256; K = 2048; off = W_CMP1 + (id - 4) * SZ_CMP1; }
    else if (id < 10) { N = 2 * FF; K = 1024; off = W_GU + (id - 6) * SZ_GU; }
    else if (id < 14) { N = 1024; K = FF; off = W_DN + (id - 10) * SZ_DN; }
    else if (id == 14) { N = 3328; K = 2048; off = W_RIN; }
    else if (id == 15) { N = 3072; K = 256; off = W_L2; }
    else if (id == 16) { N = 1024; K = 1024; off = W_ROUT; }
    else { N = 1024; K = 256; off = W_POOL; }
}
struct ItemSrc { const float* lp; size_t step; const float* mup; bool valid, prev; };
DI ItemSrc item_src(const P& p, int id, int k0, int c0, int lane) {
    ItemSrc it; it.mup = nullptr; it.valid = true; it.prev = false;
    const int c = c0 + lane;
    const float* W; int ldw, col, krow = k0;
    if (id < 2) { W = p.in[9] + (size_t)id * 1024 * NSA_IN; ldw = NSA_IN; col = c; it.valid = c < NSA_IN; }
    else if (id < 4) { W = p.in[14] + (size_t)(id - 2) * 1024 * 1024; ldw = 1024; col = c; }
    else if (id < 6) { W = p.in[11] + (size_t)((id - 4) * 2 + (c >> 7)) * 2048 * 128; ldw = 128; col = c & 127; }
    else if (id < 10) { const int w = c & 31; W = ((w >> 4) ? p.in[7] : p.in[6]) + (size_t)(id - 6) * 1024 * FF; ldw = FF; col = (c >> 5) * 16 + (w & 15); }
    else if (id < 14) { W = p.in[8] + (size_t)(id - 10) * FF * 1024; ldw = 1024; col = c; }
    else if (id == 14) {
        int mi; krow = k0 & 1023; it.prev = k0 < 1024;
        if (c < 3072) { const int which = c >> 10; mi = which == 0 ? 0 : (which == 1 ? 2 : 3); W = p.in[16] + (size_t)which * 1024 * 1024; ldw = 1024; col = c & 1023; }
        else if (c < 3136) { mi = 1; W = p.in[18]; ldw = 64; col = c - 3072; }
        else if (c < 3200) { mi = 4; W = p.in[21]; ldw = 64; col = c - 3136; }
        else { mi = 5; W = p.in[23]; ldw = 128; col = c - 3200; }
        it.mup = p.in[15] + mi * 1024 + krow;
    }
    else if (id == 15) {
        if (c < 1024) { W = p.in[19]; col = c; it.valid = k0 < 64; }
        else if (c < 2048) { W = p.in[22]; col = c - 1024; krow = k0 - 64; it.valid = (k0 >= 64 && k0 < 128); }
        else { W = p.in[24]; col = c - 2048; krow = k0 - 128; it.valid = k0 >= 128; }
        ldw = 1024;
    }
    else if (id == 16) { W = p.in[30]; ldw = 1024; col = c; }
    else { W = p.in[31] + (size_t)(c >> 8) * 65536; ldw = 256; col = c & 255; }
    if (!it.valid) { krow = 0; col = 0; }
    it.lp = W + (size_t)krow * ldw + col; it.step = (size_t)ldw;
    return it;
}
DI void convert_weights(const P& p, LAS unsigned char* lds, unsigned mask, int gw, int NGW, int wave, int lane) {
    LAS float* scr = (LAS float*)(lds + wave * 16896);
    int base = 0;
    for (int id = 0; id < 18; ++id) {
        if (!((mask >> id) & 1u)) continue;
        int N, K; size_t off; mat_info(id, N, K, off);
        const int nblk = N / 64, nitems = (K / 64) * nblk;
        bf16_t* WT = (bf16_t*)(p.ws + off);
        int first = (gw - base % NGW + NGW) % NGW;
        for (int r = first; r < nitems; r += NGW) {
            const int kb = r / nblk, nb = r % nblk, k0 = 64 * kb, tile = nb >> 2, wc = nb & 3;
            const int c0 = 256 * tile + 64 * wc, d0 = 256 * tile + 32 * wc;
            const ItemSrc it = item_src(p, id, k0, c0, lane);
#pragma unroll
            for (int h2 = 0; h2 < 2; ++h2) {
                float tv[32];
#pragma unroll
                for (int i = 0; i < 32; ++i) tv[i] = it.lp[(size_t)(32 * h2 + i) * it.step];
                if (it.mup) {
#pragma unroll
                    for (int i = 0; i < 32; ++i) { const float m = it.mup[32 * h2 + i]; tv[i] *= it.prev ? m : 1.f - m; }
                }
#pragma unroll
                for (int i = 0; i < 32; ++i) scr[(32 * h2 + i) * 65 + lane] = it.valid ? tv[i] : 0.f;
            }
            asm volatile("s_waitcnt lgkmcnt(0)" ::: "memory");
#pragma unroll
            for (int j = 0; j < 8; ++j) { const int cid = lane + 64 * j, n = cid >> 3, cch = cid & 7; const LAS float* sp = scr + (8 * cch) * 65 + n;
                u32x4 o; o.x = cvtpk(sp[0 * 65], sp[1 * 65]); o.y = cvtpk(sp[2 * 65], sp[3 * 65]); o.z = cvtpk(sp[4 * 65], sp[5 * 65]); o.w = cvtpk(sp[6 * 65], sp[7 * 65]);
                *(u32x4*)(WT + (size_t)(d0 + (n & 31) + 128 * (n >> 5)) * K + k0 + 8 * cch) = o; }
            asm volatile("s_waitcnt lgkmcnt(0)" ::: "memory");
        }
        base += nitems;
    }
}
DI void p0_phase(const P& p, LAS unsigned char* lds) {
    const int tid = threadIdx.x, lane = tid & 63, wave = tid >> 6, bi = blockIdx.x;
    LAS float* fl = (LAS float*)lds;
    if (bi < 96) {
        const int layer = bi / 24, n0 = (bi % 24) * 256;
        LAS float* cact = fl; LAS float* red = fl + 2048;
        for (int i = tid; i < 2048; i += 512) { const float cv = p.in[1][i]; cact[i] = cv / (1.f + __expf(-cv)); }
        __syncthreads();
        f32x4 a0 = {0.f, 0.f, 0.f, 0.f}, a1 = a0;
        const float* Wb = p.in[2] + ((size_t)layer * 1024 + wave * 128) * 6144 + n0 + 4 * lane;
        for (int kb = 0; kb < 128; kb += 32) {
            f32x4 wv[32];
#pragma unroll
            for (int k = 0; k < 32; ++k) wv[k] = *(const f32x4*)(Wb + (size_t)(kb + k) * 6144);
#pragma unroll
            for (int k = 0; k < 32; ++k) { const float c0 = cact[wave * 128 + kb + k], c1 = cact[1024 + wave * 128 + kb + k]; a0 += wv[k] * c0; a1 += wv[k] * c1; }
        }
#pragma unroll
        for (int e = 0; e < 4; ++e) { red[(wave * 2 + 0) * 256 + 4 * lane + e] = a0[e]; red[(wave * 2 + 1) * 256 + 4 * lane + e] = a1[e]; }
        __syncthreads();
        { const int b = tid >> 8, col = tid & 255; float s = 0.f;
#pragma unroll
          for (int w = 0; w < 8; ++w) s += red[(w * 2 + b) * 256 + col];
          ((float*)(p.ws + WS_MOD))[(size_t)(layer * 2 + b) * 6144 + n0 + col] = s + p.in[3][(size_t)layer * 6144 + n0 + col]; }
        __syncthreads();
    } else if (bi < 100) {
        const int it = bi - 96; const float* pos = p.in[10] + (size_t)it * 2048; const float* w1 = p.in[11] + (size_t)it * 2048 * 128;
        const int c = tid & 127, ks = tid >> 7; float s = 0.f;
        for (int kb = ks * 512; kb < ks * 512 + 512; kb += 32) {
            float wv[32];
#pragma unroll
            for (int k = 0; k < 32; ++k) wv[k] = w1[(size_t)(kb + k) * 128 + c];
#pragma unroll
            for (int k = 0; k < 32; ++k) s += pos[kb + k] * wv[k];
        }
        fl[ks * 128 + c] = s; __syncthreads();
        if (tid < 128) ((float*)(p.ws + WS_PBIAS))[it * 128 + tid] = (fl[tid] + fl[128 + tid]) + (fl[256 + tid] + fl[384 + tid]);
        __syncthreads();
    } else if (bi == 100) {
        unsigned* hb = (unsigned*)(p.ws + WS_HB);
        hb[tid] = 0u; hb[(size_t)8193 * 512 + tid] = 0u;
    }
    convert_weights(p, lds, 0x3FFFFu, bi * 8 + wave, gridDim.x * 8, wave, lane);
}

DI void norm_phase(const float* xs, float* xcopy, bf16_t* HB, const float* nw, const float* shift, const float* scale) {
    const int tid_ = TID(), lane = tid_ & 63, gw = blockIdx.x * 8 + (tid_ >> 6), NGW = gridDim.x * 8;
    f32x4 w4[4];
#pragma unroll
    for (int j = 0; j < 4; ++j) w4[j] = *(const f32x4*)(nw + 4 * lane + 256 * j);
    for (int m = gw; m < MTOK; m += 2 * NGW) {
        const int m1 = m + NGW;
        const bool has1 = m1 < MTOK;
        const f32x4* xr0 = (const f32x4*)(xs + (size_t)m * DM) + lane;
        const f32x4* xr1 = (const f32x4*)(xs + (size_t)(has1 ? m1 : m) * DM) + lane;
        f32x4 v0[4], v1[4];
#pragma unroll
        for (int j = 0; j < 4; ++j) v0[j] = xr0[64 * j];
#pragma unroll
        for (int j = 0; j < 4; ++j) v1[j] = xr1[64 * j];
        float ss0 = 0.f, ss1 = 0.f;
#pragma unroll
        for (int j = 0; j < 4; ++j) { ss0 += (v0[j][0] * v0[j][0] + v0[j][1] * v0[j][1]) + (v0[j][2] * v0[j][2] + v0[j][3] * v0[j][3]);
                                      ss1 += (v1[j][0] * v1[j][0] + v1[j][1] * v1[j][1]) + (v1[j][2] * v1[j][2] + v1[j][3] * v1[j][3]); }
#pragma unroll
        for (int o = 1; o < 64; o <<= 1) { ss0 += __shfl_xor(ss0, o); ss1 += __shfl_xor(ss1, o); }
        const float rstd0 = rsqrtf(ss0 * (1.f / DM) + RMS_EPS), rstd1 = rsqrtf(ss1 * (1.f / DM) + RMS_EPS);
        if (xcopy) { f32x4* xo = (f32x4*)(xcopy + (size_t)m * DM) + lane;
#pragma unroll
            for (int j = 0; j < 4; ++j) xo[64 * j] = v0[j];
            if (has1) { f32x4* xo1 = (f32x4*)(xcopy + (size_t)m1 * DM) + lane;
#pragma unroll
                for (int j = 0; j < 4; ++j) xo1[64 * j] = v1[j]; } }
        { const int b = m >> 13; bf16_t* ho = HB + (size_t)(m + 1 + b) * DM;
#pragma unroll
          for (int j = 0; j < 4; ++j) { const int col = 4 * lane + 256 * j;
              const f32x4 sc4 = *(const f32x4*)(scale + b * 6144 + col), sh4 = *(const f32x4*)(shift + b * 6144 + col);
              st_bf4(ho + col, (v0[j] * rstd0) * w4[j] * (sc4 + 1.f) + sh4); } }
        if (has1) { const int b = m1 >> 13; bf16_t* ho = HB + (size_t)(m1 + 1 + b) * DM;
#pragma unroll
          for (int j = 0; j < 4; ++j) { const int col = 4 * lane + 256 * j;
              const f32x4 sc4 = *(const f32x4*)(scale + b * 6144 + col), sh4 = *(const f32x4*)(shift + b * 6144 + col);
              st_bf4(ho + col, (v1[j] * rstd1) * w4[j] * (sc4 + 1.f) + sh4); } }
    }
}

DI void cmp2_phase(const P& p, int j, LAS unsigned char* lds) {
    const int tid_ = TID(), lane = tid_ & 63, wave = tid_ >> 6, gw = blockIdx.x * 8 + wave, NGW = gridDim.x * 8;
    const float* CMPH = (const float*)(WSP(p, R_CMPH));
    const float* pbp = (const float*)(WSP(p, WS_PBIAS)) + j * 256;
    const float* w2b = INP(p, 12) + (size_t)(j * 2) * 128 * 64; const float* qn1 = INP(p, 13) + (size_t)(j * 4 + 1) * 64;
    bf16_t* KCo = (bf16_t*)(WSP(p, R_KCMP)); bf16_t* VCo = (bf16_t*)(WSP(p, R_VCMP));
    LAS float* w2s = (LAS float*)lds;
    LAS float* hrow = (LAS float*)(lds + 65536) + wave * 128;
    for (int e = tid_; e < 2 * 128 * 64; e += 512) w2s[e] = w2b[e];
    __syncthreads();
    for (int row = gw; row < 8192; row += NGW) {
        const int slab = row >> 9, n = row & 511, kv = slab >> 3;
        f32x2 hp[8];
#pragma unroll
        for (int ks = 0; ks < 8; ++ks) hp[ks] = *(const f32x2*)(CMPH + (size_t)ks * 8192 * 128 + (size_t)row * 128 + 2 * lane);
        f32x2 h2 = *(const f32x2*)(pbp + kv * 128 + 2 * lane);
#pragma unroll
        for (int ks = 0; ks < 8; ++ks) h2 = h2 + hp[ks];
        hrow[2 * lane] = gelu_tanh(h2[0]); hrow[2 * lane + 1] = gelu_tanh(h2[1]);
        asm volatile("s_waitcnt lgkmcnt(0)" ::: "memory");
        const LAS float* w2 = w2s + kv * 8192 + lane;
        float a0 = 0.f, a1 = 0.f;
#pragma unroll 16
        for (int c = 0; c < 128; c += 2) { a0 += hrow[c] * w2[c * 64]; a1 += hrow[c + 1] * w2[(c + 1) * 64]; }
        const float acc = a0 + a1;
        float o = acc;
        if (kv == 0) { const float ss = wave_sum(acc * acc); o = acc * rsqrtf(ss * (1.f / 64.f) + RMS_EPS) * qn1[lane]; }
        if (n == 511) o = 0.f;
        bf16_t* dst = (kv == 0 ? KCo : VCo) + (size_t)(slab & 7) * 512 * 64 + (size_t)n * 64 + lane;
        *dst = f2bf(o);
        asm volatile("s_waitcnt lgkmcnt(0)" ::: "memory");
    }
}

constexpr int A_KT = 0, A_VT = 9216, A_BUF = 18432, A_IMP = 2 * A_BUF, A_SELM = A_IMP + 64 * 129 * 4, A_UNI = A_SELM + 1024, A_OAS = A_UNI + 16, A_END = A_OAS + 65536;
static_assert(A_END <= 143360 - 16 - 256, "attention LDS");
#define ABAR() do { asm volatile("s_waitcnt lgkmcnt(0)" ::: "memory"); __builtin_amdgcn_s_barrier(); asm volatile("" ::: "memory"); } while (0)
#define MFMA32(a, b, c) __builtin_amdgcn_mfma_f32_32x32x16_bf16((a), (b), (c), 0, 0, 0)
DI float xhalf_max(float v) { auto rr = __builtin_amdgcn_permlane32_swap(__float_as_uint(v), __float_as_uint(v), false, false); return fmaxf(__uint_as_float(rr[0]), __uint_as_float(rr[1])); }
DI float xhalf_other(float v, int hi) { auto rr = __builtin_amdgcn_permlane32_swap(__float_as_uint(v), __float_as_uint(v), false, false); return __uint_as_float(hi ? rr[0] : rr[1]); }
DI float xhalf_sum(float v) { auto rr = __builtin_amdgcn_permlane32_swap(__float_as_uint(v), __float_as_uint(v), false, false); return __uint_as_float(rr[0]) + __uint_as_float(rr[1]); }

struct KVRegs { u32x4 k, v; };
DI void kv_load(KVRegs& r, const bf16_t* Kg, const bf16_t* Vg, int tid) {
    r.k = *(const u32x4*)(Kg + tid * 8);
    if (Vg) r.v = *(const u32x4*)(Vg + (tid & 63) * 64 + (tid >> 6) * 8);
}
DI void kv_store(const KVRegs& r, LAS unsigned char* lds, int tid, bool hasv) {
    const int row = tid >> 3, ch = tid & 7;
    *(LAS u32x4*)(lds + A_KT + row * 144 + ch * 16) = r.k;
    if (hasv) {
        LAS bf16_t* vt = (LAS bf16_t*)(lds + A_VT); const int key = tid & 63, dch = tid >> 6;
#pragma unroll
        for (int e = 0; e < 4; ++e) { const unsigned w = r.v[e]; vt[(dch * 8 + 2 * e) * 68 + key] = (bf16_t)(w & 0xffffu); vt[(dch * 8 + 2 * e + 1) * 68 + key] = (bf16_t)(w >> 16); }
    }
}
DI void tile_scores(f32x16& s0, f32x16& s1, const LAS unsigned char* lds, const bf16x8 (&qr)[4], float bb, float cstep, int r32, int hi) {
    asm volatile("" : "+v"(hi), "+v"(r32));
    const float bb2 = bb + cstep * (float)(4 * hi);
#pragma unroll
    for (int i = 0; i < 16; ++i) { s0[i] = fmaf(cstep, (float)((i & 3) + 8 * (i >> 2)), bb2); s1[i] = fmaf(cstep, (float)((i & 3) + 8 * (i >> 2) + 32), bb2); }
    const LAS unsigned char* kp = lds + A_KT + r32 * 144 + hi * 16;
#pragma unroll
    for (int s = 0; s < 4; ++s) {
        const bf16x8 a0 = *(const LAS bf16x8*)(kp + s * 32), a1 = *(const LAS bf16x8*)(kp + 32 * 144 + s * 32);
        s0 = MFMA32(a0, qr[s], s0); s1 = MFMA32(a1, qr[s], s1);
    }
}
DI void mask_range(f32x16& s0, f32x16& s1, int klo, int khi, int hi) {
    asm volatile("" : "+v"(hi));
#pragma unroll
    for (int i = 0; i < 16; ++i) { const int k = crow(i, hi); s0[i] = (k >= klo && k <= khi) ? s0[i] : -INFINITY; s1[i] = (k + 32 >= klo && k + 32 <= khi) ? s1[i] : -INFINITY; }
}
DI void mask_le(f32x16& s0, f32x16& s1, int khi, int hi) {
    asm volatile("" : "+v"(hi));
    const int kh = khi - 4 * hi;
#pragma unroll
    for (int i = 0; i < 16; ++i) { const int k = (i & 3) + 8 * (i >> 2); s0[i] = (k <= kh) ? s0[i] : -INFINITY; s1[i] = (k + 32 <= kh) ? s1[i] : -INFINITY; }
}
DI void mask_ge(f32x16& s0, f32x16& s1, int klo, int hi) {
    asm volatile("" : "+v"(hi));
    const int kl = klo - 4 * hi;
#pragma unroll
    for (int i = 0; i < 16; ++i) { const int k = (i & 3) + 8 * (i >> 2); s0[i] = (k >= kl) ? s0[i] : -INFINITY; s1[i] = (k + 32 >= kl) ? s1[i] : -INFINITY; }
}
DI void mask_lane(f32x16& s0, f32x16& s1, bool keep) {
#pragma unroll
    for (int i = 0; i < 16; ++i) { s0[i] = keep ? s0[i] : -INFINITY; s1[i] = keep ? s1[i] : -INFINITY; }
}
DI float tile_max(const f32x16& s0, const f32x16& s1) {
    float a = fmaxf(s0[0], s1[0]);
#pragma unroll
    for (int i = 1; i < 16; ++i) a = fmaxf(a, fmaxf(s0[i], s1[i]));
    return xhalf_max(a);
}
DI void pv_tile(f32x16& o0, f32x16& o1, const f32x16& p0, const f32x16& p1, const LAS unsigned char* lds, int r32, int hi) {
    asm volatile("" : "+v"(hi), "+v"(r32));
    const LAS unsigned char* vp = lds + A_VT;
    u32x4 av[4][2];
#pragma unroll
    for (int ks = 0; ks < 4; ++ks) { const int kb = 16 * ks + 4 * hi;
#pragma unroll
        for (int dt = 0; dt < 2; ++dt) { const LAS unsigned char* a = vp + ((32 * dt + r32) * 68 + kb) * 2;
            const u32x2 lo = *(const LAS u32x2*)a, hi8 = *(const LAS u32x2*)(a + 16); av[ks][dt] = (u32x4){lo.x, lo.y, hi8.x, hi8.y}; } }
    __builtin_amdgcn_sched_barrier(0x7);
#pragma unroll
    for (int ks = 0; ks < 4; ++ks) {
        const f32x16& pp = ks < 2 ? p0 : p1; const int o8 = 8 * (ks & 1);
        u32x4 pw; pw.x = cvtpk(pp[o8 + 0], pp[o8 + 1]); pw.y = cvtpk(pp[o8 + 2], pp[o8 + 3]); pw.z = cvtpk(pp[o8 + 4], pp[o8 + 5]); pw.w = cvtpk(pp[o8 + 6], pp[o8 + 7]);
        const bf16x8 pb = __builtin_bit_cast(bf16x8, pw);
        o0 = MFMA32(__builtin_bit_cast(bf16x8, av[ks][0]), pb, o0); o1 = MFMA32(__builtin_bit_cast(bf16x8, av[ks][1]), pb, o1);
    }
}
DI void online_step(float& m, float& l, f32x16& o0, f32x16& o1, f32x16& s0, f32x16& s1) {
    const float mx = tile_max(s0, s1);
    const float mn = fmaxf(m, mx);
    const float mu = (mn == -INFINITY) ? 0.f : mn;
    const float alpha = __builtin_amdgcn_exp2f(m - mu);
    float ls = 0.f;
#pragma unroll
    for (int i = 0; i < 16; ++i) { s0[i] = __builtin_amdgcn_exp2f(s0[i] - mu); s1[i] = __builtin_amdgcn_exp2f(s1[i] - mu); ls += s0[i] + s1[i]; }
    l = l * alpha + ls;
#pragma unroll
    for (int i = 0; i < 16; ++i) { o0[i] *= alpha; o1[i] *= alpha; }
    m = mn;
}

typedef float f32x8 __attribute__((ext_vector_type(8)));
DI void fixed_step(float& l, f32x16& s0, f32x16& s1) {
#pragma unroll
    for (int i = 0; i < 16; ++i) { s0[i] = __builtin_amdgcn_exp2f(s0[i]); s1[i] = __builtin_amdgcn_exp2f(s1[i]); }
    const f32x16 v = s0 + s1;
    const f32x8 a8 = __builtin_shufflevector(v, v, 0, 1, 2, 3, 4, 5, 6, 7) + __builtin_shufflevector(v, v, 8, 9, 10, 11, 12, 13, 14, 15);
    const f32x4 a4 = __builtin_shufflevector(a8, a8, 0, 1, 2, 3) + __builtin_shufflevector(a8, a8, 4, 5, 6, 7);
    const f32x2 a2 = __builtin_shufflevector(a4, a4, 0, 1) + __builtin_shufflevector(a4, a4, 2, 3);
    l += a2[0] + a2[1];
}
DI void stats_step(float& m, float& l, const f32x16& s0, const f32x16& s1) {
    const float mx = tile_max(s0, s1);
    const float mn = fmaxf(m, mx);
    const float mu = (mn == -INFINITY) ? 0.f : mn;
    float ls = 0.f;
#pragma unroll
    for (int i = 0; i < 16; ++i) ls += __builtin_amdgcn_exp2f(s0[i] - mu) + __builtin_amdgcn_exp2f(s1[i] - mu);
    l = l * __builtin_amdgcn_exp2f(m - mu) + ls;
    m = mn;
}
DI void attn_phase(const P& p, LAS unsigned char* lds, int jl) {
    const int tid = TID(), lane = tid & 63, wid = __builtin_amdgcn_readfirstlane(tid >> 6), r32 = lane & 31, hi = lane >> 5;
    const int hh = wid & 3, qh = wid >> 2;
    float wmx[3];
    { const float* qn_ = INP(p, 13) + jl * 256;
#pragma unroll
      for (int ix = 0; ix < 3; ++ix) { float v = fabsf(qn_[(ix + 1) * 64 + lane]);
#pragma unroll
          for (int o = 1; o < 64; o <<= 1) v = fmaxf(v, __shfl_xor(v, o));
          wmx[ix] = __int_as_float(__builtin_amdgcn_readfirstlane(__float_as_int(v))); } }
    const bf16_t* Q = (const bf16_t*)(WSP(p, R_Q));
    const bf16_t* KS = (const bf16_t*)(WSP(p, R_KS)); const bf16_t* VS = (const bf16_t*)(WSP(p, R_VS));
    const bf16_t* KW = (const bf16_t*)(WSP(p, R_KW)); const bf16_t* VW = (const bf16_t*)(WSP(p, R_VW));
    const bf16_t* KC = (const bf16_t*)(WSP(p, R_KCMP)); const bf16_t* VC = (const bf16_t*)(WSP(p, R_VCMP));
    const float* GATES = (const float*)(WSP(p, R_GATES));
    bf16_t* O = (bf16_t*)(WSP(p, R_O));
    LAS float* IMP = (LAS float*)(lds + A_IMP);
    LAS unsigned* SELM = (LAS unsigned*)(lds + A_SELM);
    LAS unsigned* UNI = (LAS unsigned*)(lds + A_UNI);
    LAS float* OAS = (LAS float*)(lds + A_OAS) + tid;

    for (int u = blockIdx.x; u < 1024; u += gridDim.x) {
        const int bg = u & 7, rr_ = u >> 3, kq = rr_ >> 5, wq = rr_ & 31, qb = 32 * kq + ((kq & 1) ? 31 - wq : wq);
        const int b = bg >> 2, g = bg & 3, head = g * 4 + hh, qloc = qh * 32 + r32, t = qb * 64 + qloc, tref = qb * 64;
        const float slope2 = exp2f(-0.5f * (float)(head + 1)) * LOG2E;
        bf16x8 qr[4];
        { const bf16_t* qp = Q + ((size_t)(b * SEQ + t)) * DM + head * 64 + hi * 8;
#pragma unroll
          for (int s = 0; s < 4; ++s) qr[s] = *(const bf16x8*)(qp + s * 16); }
        float qn2 = 0.f;
#pragma unroll
        for (int s_ = 0; s_ < 4; ++s_)
#pragma unroll
            for (int e = 0; e < 8; ++e) { const float x = __uint_as_float(((unsigned)(unsigned short)qr[s_][e]) << 16); qn2 += x * x; }
        const float qnb = sqrtf(xhalf_sum(qn2)) * (8.f * 1.02f);
        for (int i = tid; i < 64 * 129; i += 512) IMP[i] = 0.f;
        if (tid < 256) SELM[tid] = 0u;
        if (tid < 4) UNI[tid] = 0u;
        const size_t bgoff = (size_t)(b * 4 + g);
        KVRegs kr;
        const int ncmp = 4 * qb + 3;
        const int ncb = (ncmp + 63) >> 6;
        const int nmaxq = (t - 31) >> 4;
        const bf16_t* KCb = KC + bgoff * 512 * 64; const bf16_t* VCb = VC + bgoff * 512 * 64;
        float lc = 0.f;
        {
            __syncthreads();
            kv_load(kr, KCb, nullptr, tid); kv_store(kr, lds, tid, false);
            if (ncb > 1) kv_load(kr, KCb + 4096, nullptr, tid);
            ABAR();
            for (int cb = 0; cb < ncb; ++cb) {
                LAS unsigned char* lb = lds + (cb & 1) * A_BUF;
                if (cb + 1 < ncb) { kv_store(kr, lds + ((cb + 1) & 1) * A_BUF, tid, false); if (cb + 2 < ncb) kv_load(kr, KCb + (size_t)(cb + 2) * 4096, nullptr, tid); }
                f32x16 s0, s1;
                tile_scores(s0, s1, lb, qr, slope2 * (float)(1024 * cb + 31 - tref) - (slope2 * (float)qloc + qnb * wmx[0]), slope2 * 16.f, r32, hi);
                mask_le(s0, s1, nmaxq - 64 * cb, hi);
                fixed_step(lc, s0, s1);
                ABAR();
            }
            lc = xhalf_sum(lc);
        }
        {
            const float rl = lc > 0.f ? 1.f / lc : 0.f; const float gate_c = (GATES + (size_t)(b * SEQ + t) * 48 + head)[0];
            float carry = 0.f;
            f32x16 oa0, oa1;
#pragma unroll
            for (int i = 0; i < 16; ++i) { oa0[i] = 0.f; oa1[i] = 0.f; }
            kv_load(kr, KCb, VCb, tid); kv_store(kr, lds, tid, true);
            if (ncb > 1) kv_load(kr, KCb + 4096, VCb + 4096, tid);
            ABAR();
            for (int cb = 0; cb < ncb; ++cb) {
                LAS unsigned char* lb = lds + (cb & 1) * A_BUF;
                if (cb + 1 < ncb) { kv_store(kr, lds + ((cb + 1) & 1) * A_BUF, tid, true); if (cb + 2 < ncb) kv_load(kr, KCb + (size_t)(cb + 2) * 4096, VCb + (size_t)(cb + 2) * 4096, tid); }
                f32x16 s0, s1;
                tile_scores(s0, s1, lb, qr, slope2 * (float)(1024 * cb + 31 - tref) - (slope2 * (float)qloc + qnb * wmx[0]), slope2 * 16.f, r32, hi);
                mask_le(s0, s1, nmaxq - 64 * cb, hi);
#pragma unroll
                for (int i = 0; i < 16; ++i) { s0[i] = __builtin_amdgcn_exp2f(s0[i]) * rl; s1[i] = __builtin_amdgcn_exp2f(s1[i]) * rl; }
                float g4[8], pl[8];
#pragma unroll
                for (int ib = 0; ib < 4; ++ib) { g4[ib] = (s0[4 * ib] + s0[4 * ib + 1]) + (s0[4 * ib + 2] + s0[4 * ib + 3]); pl[ib] = s0[4 * ib + 3];
                                                 g4[4 + ib] = (s1[4 * ib] + s1[4 * ib + 1]) + (s1[4 * ib + 2] + s1[4 * ib + 3]); pl[4 + ib] = s1[4 * ib + 3]; }
                float ppl[8], add[8];
#pragma unroll
                for (int q8 = 0; q8 < 8; ++q8) ppl[q8] = xhalf_other(pl[q8], hi);
#pragma unroll
                for (int q8 = 0; q8 < 8; ++q8) add[q8] = hi ? ppl[q8] : (q8 > 0 ? ppl[q8 - 1] : carry);
                carry = ppl[7];
#pragma unroll
                for (int i = 0; i < 16; ++i) { s0[i] *= gate_c; s1[i] *= gate_c; }
                pv_tile(oa0, oa1, s0, s1, lb, r32, hi);
                for (int turn = 0; turn < 4; ++turn) {
                    if (hh == turn) {
#pragma unroll
                        for (int q8 = 0; q8 < 8; ++q8) { const int j0 = 16 * cb + 2 * q8 + hi; if (j0 < 128) IMP[qloc * 129 + j0] += g4[q8] + add[q8]; }
                    }
                    ABAR();
                }
            }
#pragma unroll
            for (int i = 0; i < 16; ++i) { OAS[i * 512] = oa0[i]; OAS[(16 + i) * 512] = oa1[i]; }
        }
        __syncthreads();
        {
            const int q = tid >> 3, part = tid & 7;
            int val[16]; unsigned mysel = 0u;
#pragma unroll
            for (int e = 0; e < 16; ++e) { const int j = part * 16 + e; val[e] = (j >= 1 && j <= qb - 2) ? __float_as_int(IMP[q * 129 + j]) : -1; }
            const int nf = qb == 0 ? 1 : (qb == 1 ? 2 : 3);
            for (int round = 0; round < 16 - nf; ++round) {
                int lm = val[0];
#pragma unroll
                for (int e = 1; e < 16; ++e) lm = max(lm, val[e]);
                lm = max(lm, dpp_i<0xB1>(lm)); lm = max(lm, dpp_i<0x4E>(lm)); lm = max(lm, dpp_i<0x141>(lm));
                int jm = 255;
#pragma unroll
                for (int e = 0; e < 16; ++e) jm = (val[e] == lm) ? min(jm, part * 16 + e) : jm;
                jm = min(jm, dpp_i<0xB1>(jm)); jm = min(jm, dpp_i<0x4E>(jm)); jm = min(jm, dpp_i<0x141>(jm));
                if (lm >= 0) {
#pragma unroll
                    for (int e = 0; e < 16; ++e) if (part * 16 + e == jm) { val[e] = -1; mysel |= 1u << e; }
                }
            }
#pragma unroll
            for (int e = 0; e < 16; ++e) { const int j = part * 16 + e; if (j == 0 || j == qb || j == qb - 1) mysel |= 1u << e; }
            if (mysel) { const unsigned w = mysel << ((part & 1) * 16); atomicOr((unsigned*)&SELM[q * 4 + (part >> 1)], w); atomicOr((unsigned*)&UNI[part >> 1], w); }
        }
        __syncthreads();
        {
            const unsigned sw0 = SELM[qloc * 4 + 0], sw1 = SELM[qloc * 4 + 1], sw2 = SELM[qloc * 4 + 2], sw3 = SELM[qloc * 4 + 3];
            const unsigned un0 = UNI[0], un1 = UNI[1], un2 = UNI[2], un3 = UNI[3];
            float ls = 0.f; f32x16 o0, o1;
#pragma unroll
            for (int i = 0; i < 16; ++i) { o0[i] = 0.f; o1[i] = 0.f; }
            const bf16_t* Kb = KS + bgoff * 524288; const bf16_t* Vb = VS + bgoff * 524288;
            auto ubit = [&](int j) -> bool { const unsigned w = (j >> 5) == 0 ? un0 : ((j >> 5) == 1 ? un1 : ((j >> 5) == 2 ? un2 : un3)); return (w >> (j & 31)) & 1u; };
            int j = 0, it = 0;
            int jn = 1; while (jn <= qb && !ubit(jn)) ++jn;
            kv_load(kr, Kb, Vb, tid); kv_store(kr, lds, tid, true);
            if (jn <= qb) kv_load(kr, Kb + (size_t)jn * 4096, Vb + (size_t)jn * 4096, tid);
            ABAR();
            while (j <= qb) {
                LAS unsigned char* lb = lds + (it & 1) * A_BUF;
                int jnn = jn + 1; while (jnn <= qb && !ubit(jnn)) ++jnn;
                if (jn <= qb) { kv_store(kr, lds + ((it + 1) & 1) * A_BUF, tid, true); if (jnn <= qb) kv_load(kr, Kb + (size_t)jnn * 4096, Vb + (size_t)jnn * 4096, tid); }
                const unsigned w = (j >> 5) == 0 ? sw0 : ((j >> 5) == 1 ? sw1 : ((j >> 5) == 2 ? sw2 : sw3));
                const bool sel = (w >> (j & 31)) & 1u;
                if (__any(sel)) {
                    f32x16 s0, s1;
                    tile_scores(s0, s1, lb, qr, sel ? slope2 * (float)(64 * j - tref) - (slope2 * (float)qloc + qnb * wmx[1]) : -INFINITY, slope2, r32, hi);
                    if (j == qb) mask_le(s0, s1, qloc, hi);
                    fixed_step(ls, s0, s1);
                    pv_tile(o0, o1, s0, s1, lb, r32, hi);
                }
                ABAR();
                j = jn; jn = jnn; ++it;
            }
            ls = xhalf_sum(ls);
            const float f = (GATES + (size_t)(b * SEQ + t) * 48 + head)[16] * (ls > 0.f ? 1.f / ls : 0.f);
#pragma unroll
            for (int i = 0; i < 16; ++i) { OAS[i * 512] += f * o0[i]; OAS[(16 + i) * 512] += f * o1[i]; }
        }
        {
            float lw = 0.f; f32x16 o0, o1;
#pragma unroll
            for (int i = 0; i < 16; ++i) { o0[i] = 0.f; o1[i] = 0.f; }
            const bf16_t* Kb = KW + bgoff * 524288; const bf16_t* Vb = VW + bgoff * 524288;
            const int j0 = qb >= 8 ? qb - 8 : 0;
            kv_load(kr, Kb + (size_t)j0 * 4096, Vb + (size_t)j0 * 4096, tid); kv_store(kr, lds, tid, true);
            if (j0 + 1 <= qb) kv_load(kr, Kb + (size_t)(j0 + 1) * 4096, Vb + (size_t)(j0 + 1) * 4096, tid);
            ABAR();
            for (int j = j0; j <= qb; ++j) {
                LAS unsigned char* lb = lds + ((j - j0) & 1) * A_BUF;
                if (j + 1 <= qb) { kv_store(kr, lds + ((j - j0 + 1) & 1) * A_BUF, tid, true); if (j + 2 <= qb) kv_load(kr, Kb + (size_t)(j + 2) * 4096, Vb + (size_t)(j + 2) * 4096, tid); }
                f32x16 s0, s1;
                tile_scores(s0, s1, lb, qr, slope2 * (float)(64 * j - tref) - (slope2 * (float)qloc + qnb * wmx[2]), slope2, r32, hi);
                if (j == qb) mask_le(s0, s1, qloc, hi);
                else if (j == qb - 8) mask_ge(s0, s1, qloc + 1, hi);
                fixed_step(lw, s0, s1);
                pv_tile(o0, o1, s0, s1, lb, r32, hi);
                ABAR();
            }
            lw = xhalf_sum(lw);
            const float f = (GATES + (size_t)(b * SEQ + t) * 48 + head)[32] * (lw > 0.f ? 1.f / lw : 0.f);
            f32x16 oa0, oa1;
#pragma unroll
            for (int i = 0; i < 16; ++i) { oa0[i] = OAS[i * 512] + f * o0[i]; oa1[i] = OAS[(16 + i) * 512] + f * o1[i]; }
          bf16_t* op = O + (size_t)(b * SEQ + t) * DM + head * 64 + 4 * hi;
#pragma unroll
          for (int ib = 0; ib < 4; ++ib) {
              st_bf4(op + 8 * ib, (f32x4){oa0[4 * ib], oa0[4 * ib + 1], oa0[4 * ib + 2], oa0[4 * ib + 3]});
              st_bf4(op + 32 + 8 * ib, (f32x4){oa1[4 * ib], oa1[4 * ib + 1], oa1[4 * ib + 2], oa1[4 * ib + 3]}); } }
        __syncthreads();
    }
}

template <int CTRL> DI float dpp_f(float v) { return __int_as_float(__builtin_amdgcn_update_dpp(0, __float_as_int(v), CTRL, 0xf, 0xf, false)); }
DI float allreduce16(float v) { v += dpp_f<0xB1>(v); v += dpp_f<0x4E>(v); v += dpp_f<0x141>(v); v += dpp_f<0x140>(v); return v; }
DI void unpack8(const u32x4& w, float* f) {
#pragma unroll
    for (int e = 0; e < 4; ++e) { f[2 * e] = __uint_as_float(w[e] << 16); f[2 * e + 1] = __uint_as_float(w[e] & 0xffff0000u); }
}
DI float quad_sum(float v) { v += dpp_f<0xB1>(v); v += dpp_f<0x4E>(v); return v; }
DI void rwkv_prep_phase(const P& p) {
    const int tid_ = TID(), lane = tid_ & 63, gw = blockIdx.x * 8 + (tid_ >> 6), NGW = gridDim.x * 8;
    const bf16_t* RKV = (const bf16_t*)(WSP(p, R_RKV)); const bf16_t* WAG = (const bf16_t*)(WSP(p, R_WAG));
    f32x4* SC = (f32x4*)(WSP(p, R_LORAH));
    const float* kkp = INP(p, 25) + 16 * lane; const float* kap = INP(p, 26) + 16 * lane; const float* rkp = INP(p, 27) + 16 * lane;
    for (int m = gw; m < MTOK; m += NGW) {
        const int t = m & 8191; const size_t idx = (size_t)m * DM + 16 * lane; const size_t idn = (size_t)(t < SEQ - 1 ? m + 1 : m) * DM + 16 * lane;
        float r[16], k[16], kn[16], a[16];
        { const u32x4* q; q = (const u32x4*)(RKV + idx); const u32x4 r0 = q[0], r1 = q[1]; q = (const u32x4*)(RKV + (size_t)MTOK * DM + idx); const u32x4 k0 = q[0], k1 = q[1];
          q = (const u32x4*)(RKV + (size_t)MTOK * DM + idn); const u32x4 n0 = q[0], n1 = q[1]; q = (const u32x4*)(WAG + (size_t)MTOK * DM + idx); const u32x4 a0 = q[0], a1 = q[1];
          unpack8(r0, r); unpack8(r1, r + 8); unpack8(k0, k); unpack8(k1, k + 8); unpack8(n0, kn); unpack8(n1, kn + 8); unpack8(a0, a); unpack8(a1, a + 8); }
        float s0 = 0.f, s1 = 0.f;
#pragma unroll
        for (int e = 0; e < 16; ++e) { const float x0 = k[e] * kkp[e], x1 = kn[e] * kkp[e]; s0 += x0 * x0; s1 += x1 * x1; }
        const float rs0 = rsqrtf(fmaxf(quad_sum(s0), 1e-24f)), rs1 = rsqrtf(fmaxf(quad_sum(s1), 1e-24f));
        float c1 = 0.f, c2 = 0.f, bn = 0.f;
#pragma unroll
        for (int e = 0; e < 16; ++e) { const float kk = k[e] * kkp[e] * rs0, kx = kn[e] * kkp[e] * rs1, kp = k[e] * (1.f + (a[e] - 1.f) * kap[e]);
            c1 += kk * a[e] * kx; c2 += kp * kx; bn += r[e] * kp * rkp[e]; }
        c1 = quad_sum(c1); c2 = quad_sum(c2); bn = quad_sum(bn);
        if ((lane & 3) == 0) SC[(size_t)m * 16 + (lane >> 2)] = (f32x4){rs0, c1, c2, bn};
    }
}
DI float wave_sum_fast(float v) {
    v = allreduce16(v);
    const int vi = __float_as_int(v);
    const float r0 = __int_as_float(__builtin_amdgcn_readlane(vi, 0)), r1 = __int_as_float(__builtin_amdgcn_readlane(vi, 16)), r2 = __int_as_float(__builtin_amdgcn_readlane(vi, 32)), r3 = __int_as_float(__builtin_amdgcn_readlane(vi, 48));
    return (r0 + r1) + (r2 + r3);
}
#define SCAN_BAR() do { asm volatile("s_waitcnt lgkmcnt(0)" ::: "memory"); __builtin_amdgcn_s_barrier(); asm volatile("" ::: "memory"); } while (0)
DI float allreduce8(float v) { v += dpp_f<0xB1>(v); v += dpp_f<0x4E>(v); v += dpp_f<0x141>(v); return v; }
constexpr int SC_CH = 16;
constexpr int SC_BUF_F = 5 * SC_CH * 64 + SC_CH * 64 + 2 * SC_CH;
constexpr int SC_Y_F = SC_CH * 8 * 8;
constexpr int SC_OFF_Y = 4 * SC_BUF_F, SC_OFF_KK0 = SC_OFF_Y + 6 * SC_Y_F, SC_OFF_TAB = SC_OFF_KK0 + 64;
static_assert((SC_OFF_TAB + 16) * 4 <= 143360 - 16 - 256, "scan LDS");
DI void scan_phase(const P& p, LAS unsigned char* lds) {
    const int tid = TID(), lane = tid & 63, wv = __builtin_amdgcn_readfirstlane(tid >> 6);
    const int chain = blockIdx.x >> 3, r8 = blockIdx.x & 7, b = chain >> 4, h = chain & 15;
    LAS float* fl = (LAS float*)lds;
    int role = 0, ridx = 0;
    {
        LAS int* simdtab = (LAS int*)(fl + SC_OFF_TAB);
        if (lane == 0) simdtab[wv] = (int)(__builtin_amdgcn_s_getreg((1 << 11) | (4 << 6) | 4) & 3u);
        __syncthreads();
        int sid[8], rl[8];
#pragma unroll
        for (int i = 0; i < 8; ++i) { sid[i] = __builtin_amdgcn_readfirstlane(simdtab[i]); rl[i] = 2; }
        unsigned used = 0u; int ncmp = 0;
#pragma unroll
        for (int i = 0; i < 8; ++i) if (ncmp < 3 && !((used >> sid[i]) & 1u)) { rl[i] = 0; used |= 1u << sid[i]; ++ncmp; }
#pragma unroll
        for (int i = 0; i < 8; ++i) if (ncmp < 3 && rl[i] == 2) { rl[i] = 0; ++ncmp; }
        int nwr = 0;
#pragma unroll
        for (int i = 7; i >= 0; --i) if (nwr < 1 && rl[i] == 2 && ((used >> sid[i]) & 1u)) { rl[i] = 1; ++nwr; }
#pragma unroll
        for (int i = 7; i >= 0; --i) if (nwr < 1 && rl[i] == 2) { rl[i] = 1; ++nwr; }
        int cnt0 = 0, cnt1 = 0, cnt2 = 0;
#pragma unroll
        for (int i = 0; i < 8; ++i) { if (i == wv) { role = rl[i]; ridx = rl[i] == 0 ? cnt0 : (rl[i] == 1 ? cnt1 : cnt2); } cnt0 += rl[i] == 0; cnt1 += rl[i] == 1; cnt2 += rl[i] == 2; }
    }
    if (role == 2) {
        const int sg = ridx >> 1, sw = ridx & 1;
        const bf16_t* RKV = (const bf16_t*)(WSP(p, R_RKV)); const bf16_t* WAG = (const bf16_t*)(WSP(p, R_WAG));
        const bf16_t* Rg = RKV; const bf16_t* Kg = RKV + (size_t)MTOK * DM; const bf16_t* Vg = RKV + (size_t)2 * MTOK * DM;
        const bf16_t* Eg = WAG; const bf16_t* Ag = WAG + (size_t)MTOK * DM;
        const float kkc = INP(p, 25)[h * 64 + lane], kac = INP(p, 26)[h * 64 + lane];
        const f32x4* SC = (const f32x4*)(WSP(p, R_LORAH)) + h;
        bf16_t rr[8], kr[9], vr[8], er[8], ar[8]; f32x4 sc[9];
        auto load_chunk = [&](int c) {
            const int t0 = sg * 4096 + c * SC_CH + sw * 8;
#pragma unroll
            for (int s8 = 0; s8 < 8; ++s8) { const size_t tok = (size_t)(b * SEQ + t0 + s8); const size_t idx = tok * DM + h * 64 + lane;
                rr[s8] = Rg[idx]; kr[s8] = Kg[idx]; vr[s8] = Vg[idx]; er[s8] = Eg[idx]; ar[s8] = Ag[idx]; sc[s8] = SC[tok * 16]; }
            { const size_t tok = (size_t)(b * SEQ + min(t0 + 8, SEQ - 1)); kr[8] = Kg[tok * DM + h * 64 + lane]; sc[8] = SC[tok * 16]; }
        };
        auto store_chunk = [&](int bufi, bool first) {
            LAS float* bp = fl + (sg * 2 + bufi) * SC_BUF_F;
#pragma unroll
            for (int s8 = 0; s8 < 8; ++s8) { const int st = sw * 8 + s8;
                const float kf = bf2f(kr[s8]), af = bf2f(ar[s8]);
                const float w = __expf(-bf2f(er[s8])); const float kp = kf * (1.f + (af - 1.f) * kac); const float kk = kf * kkc * sc[s8][0]; const float kn = bf2f(kr[s8 + 1]) * kkc * sc[s8 + 1][0];
                if (first && sw == 0 && s8 == 0) fl[SC_OFF_KK0 + lane] = kk;
                bp[0 * SC_CH * 64 + st * 64 + lane] = w * kn; bp[1 * SC_CH * 64 + st * 64 + lane] = w; bp[2 * SC_CH * 64 + st * 64 + lane] = kk * af;
                bp[3 * SC_CH * 64 + st * 64 + lane] = kp; bp[4 * SC_CH * 64 + st * 64 + lane] = bf2f(rr[s8]); bp[5 * SC_CH * 64 + st * 64 + lane] = bf2f(vr[s8]);
                if (lane == 0) { bp[6 * SC_CH * 64 + st * 2] = sc[s8][1]; bp[6 * SC_CH * 64 + st * 2 + 1] = sc[s8][2]; } }
        };
        load_chunk(0); store_chunk(0, sg == 1); load_chunk(1);
        SCAN_BAR();
        for (int c = 0; c < 256; ++c) {
            if (c + 1 < 256) store_chunk((c + 1) & 1, false);
            if (c + 2 < 256) load_chunk(c + 2);
            SCAN_BAR();
        }
    } else if (role == 1) {
        const int idx = lane * 2, st = idx >> 3, rl = idx & 7;
        bf16_t* Y = (bf16_t*)(WSP(p, R_Y)); float* YM = (float*)(WSP(p, WS_HB));
        bf16_t* yA = Y + ((size_t)(b * SEQ + st)) * DM + h * 64 + r8 * 8 + rl; bf16_t* yC = yA + (size_t)4096 * DM;
        float* yM = YM + ((size_t)(b * 4096 + st)) * DM + h * 64 + r8 * 8 + rl;
        auto ysum = [&](const LAS float* yb, float& o0, float& o1) {
            const LAS f32x4* q = (const LAS f32x4*)(yb + idx * 8);
            const f32x4 a0 = q[0], a1 = q[1], b0 = q[2], b1 = q[3];
            const f32x4 sa_ = a0 + a1, sb_ = b0 + b1;
            o0 = (sa_[0] + sa_[1]) + (sa_[2] + sa_[3]); o1 = (sb_[0] + sb_[1]) + (sb_[2] + sb_[3]);
        };
        auto flush = [&](int c) {
            const LAS float* yb = fl + SC_OFF_Y + (c & 1) * SC_Y_F; float o0, o1; const size_t off = (size_t)c * SC_CH * DM;
            ysum(yb, o0, o1); *(unsigned*)(yA + off) = cvtpk(o0, o1);
            ysum(yb + 2 * SC_Y_F, o0, o1); *(unsigned*)(yC + off) = cvtpk(o0, o1);
            ysum(yb + 4 * SC_Y_F, o0, o1); *(f32x2*)(yM + off) = (f32x2){o0, o1};
        };
        SCAN_BAR();
        for (int c = 0; c < 256; ++c) {
            if (c > 0) flush(c - 1);
            SCAN_BAR();
        }
        flush(255);
    } else {
        const int set = ridx, sg = set == 0 ? 0 : 1, ri = lane >> 3, cq = lane & 7, row = r8 * 8 + ri;
        f32x2 s0 = {0.f, 0.f}, s1 = s0, s2 = s0, s3 = s0;
        if (set == 2) { const int d = row - 8 * cq; s0[0] = d == 0 ? 1.f : 0.f; s0[1] = d == 1 ? 1.f : 0.f; s1[0] = d == 2 ? 1.f : 0.f; s1[1] = d == 3 ? 1.f : 0.f;
                        s2[0] = d == 4 ? 1.f : 0.f; s2[1] = d == 5 ? 1.f : 0.f; s3[0] = d == 6 ? 1.f : 0.f; s3[1] = d == 7 ? 1.f : 0.f; }
        const float vmul = set == 2 ? 0.f : 1.f;
        __builtin_amdgcn_s_setprio(2);
        SCAN_BAR();
        float sa = set == 2 ? -fl[SC_OFF_KK0 + row] : 0.f;
        for (int c = 0; c < 256; ++c) {
            const LAS float* bp = fl + (sg * 2 + (c & 1)) * SC_BUF_F + 8 * cq; const LAS float* vp = fl + (sg * 2 + (c & 1)) * SC_BUF_F + 5 * SC_CH * 64 + row;
            const LAS float* cp = fl + (sg * 2 + (c & 1)) * SC_BUF_F + 6 * SC_CH * 64;
            LAS float* yb = fl + SC_OFF_Y + (set * 2 + (c & 1)) * SC_Y_F + ri * 8 + cq;
            struct StepV { f32x4 qa, qb, wa, wb, ba, bb, pa, pb, ra, rb; float vv; f32x2 cc; };
            auto ldstep = [&](int st_) -> StepV {
                StepV v_;
                v_.qa = *(const LAS f32x4*)(bp + 0 * SC_CH * 64 + st_ * 64); v_.qb = *(const LAS f32x4*)(bp + 0 * SC_CH * 64 + st_ * 64 + 4);
                v_.wa = *(const LAS f32x4*)(bp + 1 * SC_CH * 64 + st_ * 64); v_.wb = *(const LAS f32x4*)(bp + 1 * SC_CH * 64 + st_ * 64 + 4);
                v_.ba = *(const LAS f32x4*)(bp + 2 * SC_CH * 64 + st_ * 64); v_.bb = *(const LAS f32x4*)(bp + 2 * SC_CH * 64 + st_ * 64 + 4);
                v_.pa = *(const LAS f32x4*)(bp + 3 * SC_CH * 64 + st_ * 64); v_.pb = *(const LAS f32x4*)(bp + 3 * SC_CH * 64 + st_ * 64 + 4);
                v_.ra = *(const LAS f32x4*)(bp + 4 * SC_CH * 64 + st_ * 64); v_.rb = *(const LAS f32x4*)(bp + 4 * SC_CH * 64 + st_ * 64 + 4);
                v_.vv = vp[st_ * 64] * vmul; v_.cc = *(const LAS f32x2*)(cp + st_ * 2);
                return v_;
            };
            StepV c0 = ldstep(0), c1 = ldstep(1);
#pragma unroll
            for (int st = 0; st < SC_CH; ++st) {
                const StepV c2 = ldstep(st + 2 < SC_CH ? st + 2 : SC_CH - 1);
                __builtin_amdgcn_sched_barrier(0x7);
                const f32x4 qa = c0.qa, qb = c0.qb, wa = c0.wa, wb = c0.wb, ba = c0.ba, bb = c0.bb, pa = c0.pa, pb = c0.pb, ra = c0.ra, rb = c0.rb; const float vv = c0.vv; const f32x2 cc = c0.cc;
                f32x2 t = s0 * (f32x2){qa[0], qa[1]}; t = s1 * (f32x2){qa[2], qa[3]} + t;
                f32x2 t2 = s2 * (f32x2){qb[0], qb[1]}; t2 = s3 * (f32x2){qb[2], qb[3]} + t2; t = t + t2;
                const float Rp = t[0] + t[1];
                const f32x2 vk = {vv, vv}; const f32x2 sa2 = {sa, sa};
                s0 = s0 * (f32x2){wa[0], wa[1]} + (sa2 * (f32x2){ba[0], ba[1]} + vk * (f32x2){pa[0], pa[1]});
                s1 = s1 * (f32x2){wa[2], wa[3]} + (sa2 * (f32x2){ba[2], ba[3]} + vk * (f32x2){pa[2], pa[3]});
                s2 = s2 * (f32x2){wb[0], wb[1]} + (sa2 * (f32x2){bb[0], bb[1]} + vk * (f32x2){pb[0], pb[1]});
                s3 = s3 * (f32x2){wb[2], wb[3]} + (sa2 * (f32x2){bb[2], bb[3]} + vk * (f32x2){pb[2], pb[3]});
                f32x2 u = s0 * (f32x2){ra[0], ra[1]}; u = s1 * (f32x2){ra[2], ra[3]} + u;
                f32x2 u2 = s2 * (f32x2){rb[0], rb[1]}; u2 = s3 * (f32x2){rb[2], rb[3]} + u2; u = u + u2;
                yb[st * 64] = u[0] + u[1];
                const float R = allreduce8(Rp);
                sa = -(R + (sa * cc[0] + vv * cc[1]));
                c0 = c1; c1 = c2;
            }
            SCAN_BAR();
        }
        __builtin_amdgcn_s_setprio(0);
        if (set == 0) {
            float* SF = (float*)(WSP(p, R_LORAH + 4 * MiB)) + ((size_t)chain * 64 + row) * 64 + 8 * cq;
            *(f32x4*)SF = (f32x4){s0[0], s0[1], s1[0], s1[1]}; *(f32x4*)(SF + 4) = (f32x4){s2[0], s2[1], s3[0], s3[1]};
        }
    }
}
DI void scan_fixup_phase(const P& p, LAS unsigned char* lds) {
    const int tid = TID(), i = tid & 63, tq = tid >> 6;
    const int chain = blockIdx.x >> 3, slice = blockIdx.x & 7, b = chain >> 4, h = chain & 15;
    LAS float* S = (LAS float*)lds;
    const float* SF = (const float*)(WSP(p, R_LORAH + 4 * MiB)) + (size_t)chain * 4096;
    for (int e = tid; e < 4096; e += 512) S[(e >> 6) * 65 + (e & 63)] = SF[e];
    __syncthreads();
    bf16_t* Y = (bf16_t*)(WSP(p, R_Y)); const float* YM = (const float*)(WSP(p, WS_HB));
    f32x4 cur[16], nxt[16]; bf16_t ycur, ynxt;
    auto issue = [&](int g, f32x4 (&dst)[16], bf16_t& yv) {
        const int tl = slice * 512 + g * 8 + tq;
        const f32x4* ym = (const f32x4*)(YM + ((size_t)(b * 4096 + tl)) * DM + h * 64);
#pragma unroll
        for (int q4 = 0; q4 < 16; ++q4) dst[q4] = ym[q4];
        yv = Y[((size_t)(b * SEQ + 4096 + tl)) * DM + h * 64 + i];
    };
    issue(0, cur, ycur);
    for (int g = 0; g < 64; ++g) {
        if (g + 1 < 64) issue(g + 1, nxt, ynxt);
        float acc = 0.f;
#pragma unroll
        for (int q4 = 0; q4 < 16; ++q4) { const f32x4 m4 = cur[q4]; const LAS float* sr = S + i * 65 + 4 * q4; acc += (sr[0] * m4[0] + sr[1] * m4[1]) + (sr[2] * m4[2] + sr[3] * m4[3]); }
        const int tl = slice * 512 + g * 8 + tq;
        Y[((size_t)(b * SEQ + 4096 + tl)) * DM + h * 64 + i] = f2bf(bf2f(ycur) + acc);
#pragma unroll
        for (int q4 = 0; q4 < 16; ++q4) cur[q4] = nxt[q4];
        ycur = ynxt;
    }
}
DI void rwkv_gn_phase(const P& p) {
    const int tid_ = TID(), lane = tid_ & 63, gw = blockIdx.x * 8 + (tid_ >> 6), NGW = gridDim.x * 8;
    const bf16_t* RKV = (const bf16_t*)(WSP(p, R_RKV)); const bf16_t* WAG = (const bf16_t*)(WSP(p, R_WAG)); const bf16_t* Y = (const bf16_t*)(WSP(p, R_Y));
    const f32x4* SC = (const f32x4*)(WSP(p, R_LORAH));
    bf16_t* HB = (bf16_t*)(WSP(p, WS_HB));
    const float* lnw = INP(p, 28) + 16 * lane; const float* lnb = INP(p, 29) + 16 * lane;
    for (int m = gw; m < MTOK; m += NGW) {
        const int b = m >> 13; const size_t idx = (size_t)m * DM + 16 * lane;
        float y[16], v[16], g[16];
        { const u32x4* q; q = (const u32x4*)(Y + idx); const u32x4 y0 = q[0], y1 = q[1];
          q = (const u32x4*)(RKV + (size_t)2 * MTOK * DM + idx); const u32x4 v0 = q[0], v1 = q[1];
          q = (const u32x4*)(WAG + (size_t)2 * MTOK * DM + idx); const u32x4 g0 = q[0], g1 = q[1];
          unpack8(y0, y); unpack8(y1, y + 8); unpack8(v0, v); unpack8(v1, v + 8); unpack8(g0, g); unpack8(g1, g + 8); }
        const float bn = SC[(size_t)m * 16 + (lane >> 2)][3];
        float s = 0.f;
#pragma unroll
        for (int e = 0; e < 16; ++e) s += y[e];
        const float mean = quad_sum(s) * (1.f / 64.f);
        float q2 = 0.f;
#pragma unroll
        for (int e = 0; e < 16; ++e) { y[e] -= mean; q2 += y[e] * y[e]; }
        const float rstd = rsqrtf(quad_sum(q2) * (1.f / 64.f) + 64e-5f);
        u32x4 o0, o1;
#pragma unroll
        for (int e = 0; e < 4; ++e) {
            const float f0 = (y[2 * e] * rstd * lnw[2 * e] + lnb[2 * e] + bn * v[2 * e]) * g[2 * e], f1 = (y[2 * e + 1] * rstd * lnw[2 * e + 1] + lnb[2 * e + 1] + bn * v[2 * e + 1]) * g[2 * e + 1];
            const float f2 = (y[8 + 2 * e] * rstd * lnw[8 + 2 * e] + lnb[8 + 2 * e] + bn * v[8 + 2 * e]) * g[8 + 2 * e], f3 = (y[9 + 2 * e] * rstd * lnw[9 + 2 * e] + lnb[9 + 2 * e] + bn * v[9 + 2 * e]) * g[9 + 2 * e];
            o0[e] = cvtpk(f0, f1); o1[e] = cvtpk(f2, f3); }
        u32x4* op = (u32x4*)(HB + (size_t)(m + 1 + b) * DM + 16 * lane); op[0] = o0; op[1] = o1;
    }
}
DI void pool_phase(const P& p) {
    const int tid_ = TID(), lane = tid_ & 63, gw = blockIdx.x * 8 + (tid_ >> 6), NGW = gridDim.x * 8;
    const bf16_t* HB = (const bf16_t*)(WSP(p, WS_HB)); bf16_t* PO = (bf16_t*)(WSP(p, R_POOLED));
    const int win = 2 << (lane >> 4);
    for (int m = gw; m < MTOK; m += NGW) {
        const int b = m >> 13, t = m & 8191; const bf16_t* hp = HB + (size_t)(m + 1 + b) * DM + 16 * lane;
        const int nwin = min(win, t + 1);
        u32x4 lo[16], hi8[16];
#pragma unroll
        for (int u = 0; u < 16; ++u) { const int uu = u < nwin ? u : 0; lo[u] = *(const u32x4*)(hp - (size_t)uu * DM); hi8[u] = *(const u32x4*)(hp - (size_t)uu * DM + 8); }
        float acc[16], self[16];
#pragma unroll
        for (int e = 0; e < 16; ++e) acc[e] = 0.f;
#pragma unroll
        for (int u = 0; u < 16; ++u) {
            const float msk = u < nwin ? 1.f : 0.f;
#pragma unroll
            for (int e = 0; e < 4; ++e) { const float f0 = __uint_as_float(lo[u][e] << 16), f1 = __uint_as_float(lo[u][e] & 0xffff0000u), f2 = __uint_as_float(hi8[u][e] << 16), f3 = __uint_as_float(hi8[u][e] & 0xffff0000u);
                acc[2 * e] += msk * f0; acc[2 * e + 1] += msk * f1; acc[8 + 2 * e] += msk * f2; acc[8 + 2 * e + 1] += msk * f3;
                if (u == 0) { self[2 * e] = f0; self[2 * e + 1] = f1; self[8 + 2 * e] = f2; self[8 + 2 * e + 1] = f3; } }
        }
        const float inv = 1.f / (float)nwin;
        u32x4 o0, o1;
#pragma unroll
        for (int e = 0; e < 4; ++e) { o0[e] = cvtpk(acc[2 * e] * inv - self[2 * e], acc[2 * e + 1] * inv - self[2 * e + 1]); o1[e] = cvtpk(acc[8 + 2 * e] * inv - self[8 + 2 * e], acc[8 + 2 * e + 1] * inv - self[8 + 2 * e + 1]); }
        *(u32x4*)(PO + (size_t)m * DM + 16 * lane) = o0; *(u32x4*)(PO + (size_t)m * DM + 16 * lane + 8) = o1;
    }
}


#define XB_TMO      128
#define XB_XCNT(j)  (256  + 64 * (j))
#define XB_XSUB(j)  (1280 + 64 * (j))
#define XB_XGEN(j)  (2304 + 64 * (j))
#define XB_TOP      3328
#define XB_TOPGEN   3392
#define XCD_BAR_WORDS 3456
#define XB_SPIN_CAP (1u << 22)
DI unsigned xb_ld(unsigned* p) { return __hip_atomic_load(p, __ATOMIC_RELAXED, __HIP_MEMORY_SCOPE_AGENT); }
DI unsigned xb_add(unsigned* p, unsigned v) { return __hip_atomic_fetch_add(p, v, __ATOMIC_RELAXED, __HIP_MEMORY_SCOPE_AGENT); }
DI unsigned xb_xcc_id() { return (unsigned)__builtin_amdgcn_s_getreg((3 << 11) | 20) & 0xFu; }
#define XB_SPIN(cond, bar) do { unsigned _sp = 0; while (cond) { __builtin_amdgcn_s_sleep(1); \
    if ((++_sp & 255u) == 0u) { if (xb_ld(&(bar)[XB_TMO])) break; if (_sp > XB_SPIN_CAP) { atomicAdd(&(bar)[XB_TMO], 1u); break; } } } } while (0)
struct XcdBarrier { unsigned* bar; unsigned x; volatile LAS unsigned* st; };
DI XcdBarrier xcd_barrier_post(unsigned* bar, volatile LAS unsigned* st) {
    XcdBarrier b; b.bar = bar; b.x = xb_xcc_id(); b.st = st;
    if (threadIdx.x == 0) (void)xb_add(&bar[XB_XCNT(b.x)], 1u);
    return b;
}
DI void xcd_barrier_complete(unsigned* bar, unsigned x, unsigned& nloc, unsigned& nx) {
    const unsigned G = gridDim.x * gridDim.y * gridDim.z;
    unsigned sum, cnt, mine, sp = 0u;
    for (;;) {
        sum = 0u; cnt = 0u; mine = 0u;
#pragma unroll
        for (unsigned j = 0; j < 16; ++j) { const unsigned c = xb_ld(&bar[XB_XCNT(j)]); sum += c; cnt += (c > 0u) ? 1u : 0u; mine = (j == x) ? c : mine; }
        if (sum == G) break;
        __builtin_amdgcn_s_sleep(1);
        if ((++sp & 255u) == 0u) { if (xb_ld(&bar[XB_TMO])) break; if (sp > XB_SPIN_CAP) { atomicAdd(&bar[XB_TMO], 1u); break; } }
    }
    nloc = mine > 0u ? mine : 1u; nx = cnt > 0u ? cnt : 1u;
}
DI void xcd_barrier(const P& p, LAS unsigned char* lds) {
    XcdBarrier b; b.bar = (unsigned*)WSP(p, WS_BAR); b.x = xb_xcc_id(); b.st = (volatile LAS unsigned*)(lds + LDS_BYTES - 16);
    asm volatile("s_waitcnt vmcnt(0)" ::: "memory");
    __syncthreads();
    if (TID() == 0) {
        unsigned* bar = b.bar;
        __builtin_amdgcn_s_waitcnt(0);
        unsigned nloc = b.st[0], nx = b.st[1];
        if (nloc == 0u) { xcd_barrier_complete(bar, b.x, nloc, nx); b.st[0] = nloc; b.st[1] = nx; }
        const unsigned old = xb_add(&bar[XB_XSUB(b.x)], 1u);
        const unsigned gen = old / nloc;
        if (old + 1u == (gen + 1u) * nloc) {
            __builtin_amdgcn_fence(__ATOMIC_RELEASE, "agent");
            asm volatile("s_waitcnt vmcnt(0)" ::: "memory");
            const unsigned og = xb_add(&bar[XB_TOP], 1u);
            const unsigned tg = og / nx;
            if (og + 1u == (tg + 1u) * nx) xb_add(&bar[XB_TOPGEN], 1u);
            else XB_SPIN(xb_ld(&bar[XB_TOPGEN]) == tg, bar);
            __builtin_amdgcn_fence(__ATOMIC_ACQUIRE, "agent");
            xb_add(&bar[XB_XGEN(b.x)], 1u);
            asm volatile("s_waitcnt vmcnt(0)" ::: "memory");
        } else {
            XB_SPIN(xb_ld(&bar[XB_XGEN(b.x)]) == gen, bar);
            __builtin_amdgcn_fence(__ATOMIC_ACQUIRE, "agent");
            asm volatile("s_waitcnt vmcnt(0)" ::: "memory");
        }
    }
    __syncthreads();
}
__global__ void __launch_bounds__(512, 2) fwd_kernel(P p) {
    LAS unsigned char* lds = (LAS unsigned char*)lds_raw;
    if ((threadIdx.x & 63) == 0) ((volatile LAS int*)(lds + WAVEMAP_OFF))[hw_wave_key()] = (int)(threadIdx.x >> 6);
    cg::grid_group grid = cg::this_grid();
    volatile LAS unsigned* xst = (volatile LAS unsigned*)(lds + LDS_BYTES - 16);
    if (threadIdx.x < 4) xst[threadIdx.x] = 0u;
    __syncthreads();
    (void)xcd_barrier_post((unsigned*)(p.ws + WS_BAR), xst);
#define GSYNC() xcd_barrier(p, lds)
    const int G = gridDim.x, bx = blockIdx.x;
    float* x = p.out;
#define MOD ((const float*)(WSP(p, WS_MOD)))
#define HB ((bf16_t*)(WSP(p, WS_HB)))
#define HA ((const bf16_t*)(WSP(p, WS_HB + 2048)))
    pg8::StaticOrder S;

    if (PH & 1) p0_phase(p, lds);
    if (DUP & 16) { __syncthreads(); p0_phase(p, lds); }
    if (p.ws == nullptr) grid.sync();
    GSYNC();

    for (int layer = 0; layer < 4; ++layer) {
        const int kind = layer % 3, j = layer / 3;
        const float* mod = MOD + (size_t)layer * 2 * 6144;
        if (PH & 2) norm_phase(layer == 0 ? INP(p, 0) : x, nullptr, HB, INP(p, 4) + layer * DM, mod + 0, mod + 1024);
        GSYNC();
        if (kind == 0) {
            { pg8::Gemm g{HA, (const bf16_t*)(WSP(p, W_NSA_IN + j * SZ_NSA_IN)), MTOK, NSA_INP, 1024, 1024, 2048, 0}; S.init(MTOK, NSA_INP, G, bx);
              EpiNsaIn E{(bf16_t*)(WSP(p, R_Q)), (bf16_t*)(WSP(p, R_KCV)), (bf16_t*)(WSP(p, R_KS)), (bf16_t*)(WSP(p, R_VS)), (bf16_t*)(WSP(p, R_KW)), (bf16_t*)(WSP(p, R_VW)), (float*)(WSP(p, R_GATES)), INP(p, 13) + j * 256};
              for (int rep_ = 0; rep_ < ((DUP & 512) ? 2 : 1); ++rep_) { pg8::gemm_phase<EpiNsaIn>(lds, g, S, E); if (DUP & 512) GSYNC(); } }
            GSYNC();
            { pg8::Gemm g{(const bf16_t*)(WSP(p, R_KCV)), (const bf16_t*)(WSP(p, W_CMP1 + j * SZ_CMP1)), 8192, 2048, 256, 1024, 0, 512, 2048, 512}; S.init(8192, 2048, G, bx);
              EpiCmp E{(float*)(WSP(p, R_CMPH))};
              if (PH & 8) pg8::gemm_phase<EpiCmp>(lds, g, S, E); }
            GSYNC();
            if (PH & 16) cmp2_phase(p, j, lds);
            if (DUP & 256) cmp2_phase(p, j, lds);
            GSYNC();
            if (PH & 32) attn_phase(p, lds, j);
            if (DUP & 1) { GSYNC(); attn_phase(p, lds, j); }
            GSYNC();
        } else if (kind == 1) {
            { pg8::Gemm g{HB, (const bf16_t*)(WSP(p, W_RIN)), MTOK, 3328, 2048, 1024, 2048, 0}; S.init(MTOK, 3328, G, bx);
              EpiRwkvIn E{(bf16_t*)(WSP(p, R_RKV)), (bf16_t*)(WSP(p, R_LORAH))};
              for (int rep_ = 0; rep_ < ((DUP & 1024) ? 2 : 1); ++rep_) { pg8::gemm_phase<EpiRwkvIn>(lds, g, S, E); if (DUP & 1024) GSYNC(); } }
            GSYNC();
            { pg8::Gemm g{(const bf16_t*)(WSP(p, R_LORAH)), (const bf16_t*)(WSP(p, W_L2)), MTOK, 3072, 256, 256, 0, 0}; S.init(MTOK, 3072, G, bx);
              EpiLora2 E{(bf16_t*)(WSP(p, R_WAG)), INP(p, 17), INP(p, 20)};
              for (int rep_ = 0; rep_ < ((DUP & 2048) ? 2 : 1); ++rep_) { pg8::gemm_phase<EpiLora2>(lds, g, S, E); if (DUP & 2048) GSYNC(); } }
            GSYNC();
            rwkv_prep_phase(p);
            GSYNC();
            if (PH & 256) scan_phase(p, lds);
            if (DUP & 2) { GSYNC(); scan_phase(p, lds); }
            GSYNC();
            scan_fixup_phase(p, lds);
            GSYNC();
            if (PH & 512) rwkv_gn_phase(p);
            if (DUP & 64) { rwkv_gn_phase(p); rwkv_prep_phase(p); }
            GSYNC();
        } else {
            if (PH & 1024) pool_phase(p);
            if (DUP & 128) pool_phase(p);
            GSYNC();
        }
        {
            pg8::Gemm g; EpiRes E{x, mod + 2048, nullptr, nullptr, layer == 0 ? INP(p, 0) : x};
            if (kind == 0) g = pg8::Gemm{(const bf16_t*)(WSP(p, R_O)), (const bf16_t*)(WSP(p, W_NSA_OUT + j * SZ_SQ)), MTOK, 1024, 1024, 1024, 0, 0};
            else if (kind == 1) g = pg8::Gemm{HA, (const bf16_t*)(WSP(p, W_ROUT)), MTOK, 1024, 1024, 1024, 2048, 0};
            else { g = pg8::Gemm{(const bf16_t*)(WSP(p, R_POOLED)), (const bf16_t*)(WSP(p, W_POOL)), MTOK, 1024, 256, 1024, 0, 512}; E.bias = INP(p, 32); E.pscale = INP(p, 33); }
            S.init(MTOK, 1024, G, bx);
            if (PH & 2048) pg8::gemm_phase<EpiRes>(lds, g, S, E);
        }
        GSYNC();
        if (PH & 2) norm_phase(x, nullptr, HB, INP(p, 5) + layer * DM, mod + 3072, mod + 4096);
        if (DUP & 32) { norm_phase(x, nullptr, HB, INP(p, 5) + layer * DM, mod + 3072, mod + 4096); norm_phase(x, nullptr, HB, INP(p, 5) + layer * DM, mod + 3072, mod + 4096); }
        GSYNC();
        { pg8::Gemm g{HA, (const bf16_t*)(WSP(p, W_GU + layer * SZ_GU)), MTOK, 2 * FF, 1024, 1024, 2048, 0}; S.init(MTOK, 2 * FF, G, bx);
          EpiFfnUp E{(bf16_t*)(WSP(p, R_ACT))};
          if (PH & 4096) pg8::gemm_phase<EpiFfnUp>(lds, g, S, E);
          if (DUP & 4) { GSYNC(); pg8::gemm_phase<EpiFfnUp>(lds, g, S, E); } }
        GSYNC();
        { pg8::Gemm g{(const bf16_t*)(WSP(p, R_ACT)), (const bf16_t*)(WSP(p, W_DN + layer * SZ_DN)), MTOK, 1024, FF, FF, 0, 0}; S.init(MTOK, 1024, G, bx);
          EpiRes E{x, mod + 5120, nullptr, nullptr, x};
          if (PH & 8192) pg8::gemm_phase<EpiRes>(lds, g, S, E); }
        if (layer < 3) GSYNC();
        if (DUP & 8) { for (int r_ = 0; r_ < 8; ++r_) GSYNC(); }
    }
}

extern "C" void kernel_launch(void* const* d_in, const int* in_sizes, int n_in, void* d_out, int out_size, void* d_ws, size_t ws_size, hipStream_t stream) {
    static int grid = 0;
    if (grid == 0) {
        if (n_in != 34 || ws_size < WS_END) { fprintf(stderr, "kernel_launch: unexpected n_in %d or ws_size %zu (need %zu)\n", n_in, ws_size, (size_t)WS_END); grid = -1; return; }
        int dev = 0, cus = 0, per_cu = 0;
        hipGetDevice(&dev); hipDeviceGetAttribute(&cus, hipDeviceAttributeMultiprocessorCount, dev);
        hipFuncSetAttribute((const void*)fwd_kernel, hipFuncAttributeMaxDynamicSharedMemorySize, LDS_BYTES);
        hipOccupancyMaxActiveBlocksPerMultiprocessor(&per_cu, (const void*)fwd_kernel, 512, LDS_BYTES);
        if (per_cu < 1) { fprintf(stderr, "kernel_launch: occupancy query says %d blocks per CU\n", per_cu); per_cu = 1; }
        grid = cus;
    }
    if (grid < 0) return;
    P p{};
    for (int i = 0; i < 34; ++i) p.in[i] = (const float*)d_in[i];
    p.out = (float*)d_out; p.ws = (unsigned char*)d_ws;
    (void)hipMemsetAsync((char*)d_ws + WS_BAR, 0, 16384, stream);
    void* args[] = {&p};
    hipError_t e = hipLaunchCooperativeKernel((const void*)fwd_kernel, dim3(grid), dim3(512), args, LDS_BYTES, stream);
    if (e != hipSuccess) fprintf(stderr, "cooperative launch failed: %s (grid %d)\n", hipGetErrorString(e), grid);
}
```
